# Optimizing an MI355X kernel written in HIP

```python
import math
import jax, jax.numpy as jnp
from jax import lax
import numpy as np

D_MODEL = 1024
BATCH = 8
SEQ = 4096
DEPTH = 4

N_MIXERS = 3
D_FF = 4 * D_MODEL
D_MIX = D_MODEL
EPS = 1e-6
CONV_WIDTH = 3
S5_GROUP = 16
S5_GROUPS = D_MIX // S5_GROUP
S5_STATE = 64
DT_MIN = 1e-3
DT_MAX = 1e-1
CHUNK = 128
SG_HEADS = 8
SG_HEAD_DIM = D_MIX // SG_HEADS
N_A = (DEPTH + 2) // 3
N_B = (DEPTH + 1) // 3
N_C = DEPTH // 3

kernel_name = "hybrid_conv_s5_sgmlp_trunk"


def rmsnorm(x, g):
    xf = x.astype(jnp.float32)
    y = xf * lax.rsqrt(jnp.mean(xf * xf, axis=-1, keepdims=True) + EPS)
    return (y * g.astype(jnp.float32)).astype(x.dtype)


def short_conv_mixer(h, w_in, conv_w, conv_b, w_out):
    bcx = h @ w_in
    b_gate, c_gate, xh = jnp.split(bcx, 3, axis=-1)
    z = c_gate * xh
    conv = lax.conv_general_dilated(
        z, conv_w[:, None, :].astype(z.dtype), window_strides=(1,),
        padding=[(CONV_WIDTH - 1, 0)], dimension_numbers=("NWC", "WIO", "NWC"),
        feature_group_count=D_MIX) + conv_b
    return (b_gate * conv) @ w_out


def _ssm_combine(e1, e2):
    a1r, a1i, b1r, b1i = e1
    a2r, a2i, b2r, b2i = e2
    ar = a2r * a1r - a2i * a1i
    ai = a2r * a1i + a2i * a1r
    br = a2r * b1r - a2i * b1i + b2r
    bi = a2r * b1i + a2i * b1r + b2i
    return (ar, ai, br, bi)


def s5_mixer(h, w_in, a_re, a_im, log_dt, b_re, b_im, c_re, c_im, d_skip, glu_w, glu_b, w_out):
    bsz, seq_len, _ = h.shape
    f32 = jnp.float32
    u = (h @ w_in).astype(f32).reshape(bsz, seq_len, S5_GROUPS, S5_GROUP)
    a_re = a_re.astype(f32); a_im = a_im.astype(f32)
    dt = jnp.exp(log_dt.astype(f32))[:, None]
    mag = jnp.exp(a_re * dt)
    abar_re = mag * jnp.cos(a_im * dt)
    abar_im = mag * jnp.sin(a_im * dt)
    den = a_re * a_re + a_im * a_im
    nr = abar_re - 1.0
    ni = abar_im
    f_re = ((nr * a_re + ni * a_im) / den)[..., None]
    f_im = ((ni * a_re - nr * a_im) / den)[..., None]
    b_re = b_re.astype(f32); b_im = b_im.astype(f32)
    bbar_re = f_re * b_re - f_im * b_im
    bbar_im = f_re * b_im + f_im * b_re
    bu_re = jnp.einsum("blgh,gph->blgp", u, bbar_re)
    bu_im = jnp.einsum("blgh,gph->blgp", u, bbar_im)
    a_seq_re = jnp.broadcast_to(abar_re, (1, seq_len, S5_GROUPS, S5_STATE))
    a_seq_im = jnp.broadcast_to(abar_im, (1, seq_len, S5_GROUPS, S5_STATE))
    _, _, s_re, s_im = lax.associative_scan(
        _ssm_combine, (a_seq_re, a_seq_im, bu_re, bu_im), axis=1)
    y = (jnp.einsum("blgp,ghp->blgh", s_re, c_re.astype(f32))
         - jnp.einsum("blgp,ghp->blgh", s_im, c_im.astype(f32)))
    y = y + d_skip.astype(f32).reshape(S5_GROUPS, S5_GROUP) * u
    y = jax.nn.gelu(y.reshape(bsz, seq_len, D_MIX))
    y = y * jax.nn.sigmoid(y @ glu_w.astype(f32) + glu_b.astype(f32))
    return y.astype(h.dtype) @ w_out


def spatial_gating_mixer(h, w_in, v_gain, w_s, b_s, w_out):
    bsz, seq_len, _ = h.shape
    u, v = jnp.split(h @ w_in, 2, axis=-1)
    v = rmsnorm(v, v_gain)
    vc = v.reshape(bsz, seq_len // CHUNK, CHUNK, SG_HEADS, SG_HEAD_DIM)
    causal = jnp.tril(jnp.ones((CHUNK, CHUNK), dtype=bool))
    ws = jnp.where(causal[None], w_s, jnp.zeros_like(w_s))
    vm = jnp.einsum("hts,bnshd->bnthd", ws, vc) + b_s.T[:, :, None]
    return (u * vm.reshape(bsz, seq_len, D_MIX)) @ w_out


def squared_relu_mlp(h, w1, w2):
    return jnp.square(jax.nn.relu(h @ w1)) @ w2


def setup_inputs(seed: int = 0) -> dict:
    key = jax.random.key(seed)
    ks = iter(jax.random.split(key, 40))
    f32 = jnp.float32

    def nrm(shape, std):
        return std * jax.random.normal(next(ks), shape, f32)

    D = D_MODEL
    G, P = S5_GROUPS, S5_STATE
    x = nrm((BATCH, SEQ, D), 1.0)
    c = nrm((BATCH, D), 1.0)
    ada_w = nrm((DEPTH, D, 6 * D), 0.5 * D ** -0.5)
    ada_b = nrm((DEPTH, 6 * D), 0.02)
    norm1_g = 1.0 + nrm((DEPTH, D), 0.02)
    norm2_g = 1.0 + nrm((DEPTH, D), 0.02)
    ff_w1 = nrm((DEPTH, D, D_FF), D ** -0.5)
    ff_w2 = nrm((DEPTH, D_FF, D), D_FF ** -0.5)
    final_g = 1.0 + nrm((D,), 0.02)
    conv_w_in = nrm((N_A, D, 3 * D_MIX), D ** -0.5)
    conv_w = nrm((N_A, CONV_WIDTH, D_MIX), CONV_WIDTH ** -0.5)
    conv_b = nrm((N_A, D_MIX), 0.02)
    conv_w_out = nrm((N_A, D_MIX, D), D_MIX ** -0.5)
    ssm_w_in = nrm((N_B, D, D_MIX), D ** -0.5)
    ssm_a_re = -0.5 + nrm((N_B, G, P), 0.01)
    ssm_a_im = math.pi * jnp.arange(P, dtype=f32) + nrm((N_B, G, P), 0.01)
    ssm_log_dt = jax.random.uniform(next(ks), (N_B, G), f32,
                                    minval=math.log(DT_MIN), maxval=math.log(DT_MAX))
    ssm_b_re = nrm((N_B, G, P, S5_GROUP), S5_GROUP ** -0.5)
    ssm_b_im = nrm((N_B, G, P, S5_GROUP), S5_GROUP ** -0.5)
    ssm_c_re = nrm((N_B, G, S5_GROUP, P), P ** -0.5)
    ssm_c_im = nrm((N_B, G, S5_GROUP, P), P ** -0.5)
    ssm_d = nrm((N_B, D_MIX), 0.5)
    ssm_glu_w = nrm((N_B, D_MIX, D_MIX), D_MIX ** -0.5)
    ssm_glu_b = nrm((N_B, D_MIX), 0.02)
    ssm_w_out = nrm((N_B, D_MIX, D), D_MIX ** -0.5)
    sg_w_in = nrm((N_C, D, 2 * D_MIX), D ** -0.5)
    sg_v_g = 1.0 + nrm((N_C, D_MIX), 0.02)
    sg_w_s = nrm((N_C, SG_HEADS, CHUNK, CHUNK), CHUNK ** -0.5)
    sg_b_s = 1.0 + nrm((N_C, SG_HEADS, CHUNK), 0.02)
    sg_w_out = nrm((N_C, D_MIX, D), D_MIX ** -0.5)
    return {
        "x": x, "c": c, "ada_w": ada_w, "ada_b": ada_b,
        "norm1_g": norm1_g, "norm2_g": norm2_g, "ff_w1": ff_w1, "ff_w2": ff_w2,
        "final_g": final_g,
        "conv_w_in": conv_w_in, "conv_w": conv_w, "conv_b": conv_b, "conv_w_out": conv_w_out,
        "ssm_w_in": ssm_w_in, "ssm_a_re": ssm_a_re, "ssm_a_im": ssm_a_im,
        "ssm_log_dt": ssm_log_dt, "ssm_b_re": ssm_b_re, "ssm_b_im": ssm_b_im,
        "ssm_c_re": ssm_c_re, "ssm_c_im": ssm_c_im, "ssm_d": ssm_d,
        "ssm_glu_w": ssm_glu_w, "ssm_glu_b": ssm_glu_b, "ssm_w_out": ssm_w_out,
        "sg_w_in": sg_w_in, "sg_v_g": sg_v_g, "sg_w_s": sg_w_s, "sg_b_s": sg_b_s,
        "sg_w_out": sg_w_out,
    }


def reference(x, c, ada_w, ada_b, norm1_g, norm2_g, ff_w1, ff_w2, final_g,
              conv_w_in, conv_w, conv_b, conv_w_out,
              ssm_w_in, ssm_a_re, ssm_a_im, ssm_log_dt, ssm_b_re, ssm_b_im,
              ssm_c_re, ssm_c_im, ssm_d, ssm_glu_w, ssm_glu_b, ssm_w_out,
              sg_w_in, sg_v_g, sg_w_s, sg_b_s, sg_w_out):
    c_act = jax.nn.silu(c)
    for i in range(DEPTH):
        kind = i % N_MIXERS
        j = i // N_MIXERS
        mod = (c_act @ ada_w[i] + ada_b[i])[:, None, :]
        sh1, sc1, g1, sh2, sc2, g2 = jnp.split(mod, 6, axis=-1)
        h = rmsnorm(x, norm1_g[i]) * (1.0 + sc1) + sh1
        if kind == 0:
            y = short_conv_mixer(h, conv_w_in[j], conv_w[j], conv_b[j], conv_w_out[j])
        elif kind == 1:
            y = s5_mixer(h, ssm_w_in[j], ssm_a_re[j], ssm_a_im[j], ssm_log_dt[j],
                         ssm_b_re[j], ssm_b_im[j], ssm_c_re[j], ssm_c_im[j], ssm_d[j],
                         ssm_glu_w[j], ssm_glu_b[j], ssm_w_out[j])
        else:
            y = spatial_gating_mixer(h, sg_w_in[j], sg_v_g[j], sg_w_s[j], sg_b_s[j], sg_w_out[j])
        x = x + g1 * y
        h = rmsnorm(x, norm2_g[i]) * (1.0 + sc2) + sh2
        x = x + g2 * squared_relu_mlp(h, ff_w1[i], ff_w2[i])
    return rmsnorm(x, final_g)
```

```cpp
#include <hip/hip_runtime.h>
#include <hip/hip_cooperative_groups.h>
#include <cstdio>
#include <cstdint>
namespace cg = cooperative_groups;

namespace pg8 {
#define PG8_LAS __attribute__((address_space(3)))
typedef unsigned short bf16_t;
typedef short bf16x8 __attribute__((ext_vector_type(8)));
typedef float f32x4 __attribute__((ext_vector_type(4)));
typedef unsigned u32x4 __attribute__((ext_vector_type(4)));
typedef unsigned u32x2 __attribute__((ext_vector_type(2)));
constexpr int BM = 256, BK = 64, HALF = 128, HTB = HALF * BK * 2, STAGE_BYTES = 8 * HTB, NXCD = 8, WGM = 8;

__host__ __device__ __forceinline__ int lds_byte(int r, int c) { const int st = (r >> 4) * 2 + (c >> 5), rr = r & 15, cc = c & 31, ob = rr * 64 + cc * 2; return st * 1024 + (ob ^ (((ob >> 9) & 1) << 5)); }
__host__ __device__ __forceinline__ void stage_rc(int b, int& R, int& C) { const int st = b / 1024, sb = b % 1024, swz = sb ^ (((sb >> 9) & 1) << 5); R = (st >> 1) * 16 + swz / 64; C = (st & 1) * 32 + (swz % 64) / 2; }
__host__ __device__ __forceinline__ int perm32(int rho) { const int n = rho >> 4, i = rho & 15; return 8 * (i >> 2) + 4 * n + (i & 3); }

struct Unit { int pm, pn, g; };
struct Gemm { const bf16_t* A; const bf16_t* Bt; int K, lda, ldb; size_t gsA, gsB; };

struct StaticOrder {
    int nM, nN, nwg, G, c;
    __device__ void init(int M, int N, int G_, int c_) { nM = M / BM; nN = N / BM; nwg = nM * nN; G = G_; c = c_; }
    __device__ bool next(int i, Unit& u) const {
        const long L = (long)i * G + c; if (L >= nwg) return false;
        int wgid = (int)L; { const int q = nwg / NXCD, r = nwg % NXCD, xcd = wgid % NXCD, off = wgid / NXCD; wgid = (xcd < r ? xcd * (q + 1) : r * (q + 1) + (xcd - r) * q) + off; }
        const int nig = WGM * nN, gid = wgid / nig, fm = gid * WGM, gsz = (nM - fm) < WGM ? (nM - fm) : WGM;
        u.pm = fm + ((wgid % nig) % gsz); u.pn = (wgid % nig) / gsz; u.g = 0; return true;
    }
};
struct GroupOrder {
    int nM, upg, total, G, c;
    __device__ void init(int nM_, int nN_, int ngroups, int G_, int c_) { nM = nM_; upg = nM_ * nN_; total = upg * ngroups; G = G_; c = c_; }
    __device__ bool next(int i, Unit& u) const {
        const long L = (long)i * G + c; if (L >= total) return false;
        const int l = (int)L; u.g = l / upg; const int w = l % upg; u.pm = w % nM; u.pn = w / nM; return true;
    }
};

__device__ __forceinline__ unsigned cvt_pk_bf16(float lo, float hi) { unsigned r; asm volatile("v_cvt_pk_bf16_f32 %0, %1, %2" : "=v"(r) : "v"(lo), "v"(hi)); return r; }
__device__ __forceinline__ u32x4 pack8(f32x4 a, f32x4 b) { u32x4 w; w.x = cvt_pk_bf16(a[0], a[1]); w.y = cvt_pk_bf16(a[2], a[3]); w.z = cvt_pk_bf16(b[0], b[1]); w.w = cvt_pk_bf16(b[2], b[3]); return w; }
__device__ __forceinline__ void unpack8(u32x4 w, f32x4& a, f32x4& b) {
    a[0] = __uint_as_float(w.x << 16); a[1] = __uint_as_float(w.x & 0xffff0000u); a[2] = __uint_as_float(w.y << 16); a[3] = __uint_as_float(w.y & 0xffff0000u);
    b[0] = __uint_as_float(w.z << 16); b[1] = __uint_as_float(w.z & 0xffff0000u); b[2] = __uint_as_float(w.w << 16); b[3] = __uint_as_float(w.w & 0xffff0000u); }

template <class Epi, class Sched, bool ALIGN_EPI>
__device__ __forceinline__ void gemm_phase(PG8_LAS unsigned char* lds, const Gemm g, const Sched& S, const Epi& E) {
    int tid_ = threadIdx.x; asm volatile("" : "+v"(tid_));
    const int tid = tid_, wid = __builtin_amdgcn_readfirstlane(tid >> 6), lane = tid & 63, wr = wid >> 2, wc = wid & 3, fr = lane & 15, fq = lane >> 4;
    const int K = g.K, nt = K / BK;
    unsigned voffA[2], voffB[2];
#pragma unroll
    for (int i = 0; i < 2; ++i) { int R, C; stage_rc(tid * 16 + i * 8192, R, C); const int Rb = (R & ~31) + perm32(R & 31);
        voffA[i] = (unsigned)(R * g.lda + C) * 2u; voffB[i] = (unsigned)(Rb * g.ldb + C) * 2u; }
    const size_t kstep = (size_t)(BK * 2);
    const size_t hsA = (size_t)HALF * g.lda * 2, hsB = (size_t)HALF * g.ldb * 2;
    const size_t tsA = 2 * hsA, tsB = 2 * hsB;
    const unsigned ldsw = (unsigned)wid * 1024u;
    const int aoff = lds_byte(wr * 64 + fr, fq * 8), boff = lds_byte(wc * 32 + fr, fq * 8);
#define PG8_SA(b, h) (((b) * 2 + (h)) * HTB)
#define PG8_SB(b, h) ((4 + (b) * 2 + (h)) * HTB)
#define PG8_STAGE(bufoff, gbase, voff) do { _Pragma("unroll") for (int _i = 0; _i < 2; ++_i) \
        __builtin_amdgcn_global_load_lds((const unsigned*)((const char*)(gbase) + (voff)[_i]), (PG8_LAS unsigned*)(lds + (bufoff) + ldsw + _i * 8192), 16, 0, 0); } while (0)
#define PG8_LDA(dst, b, h) do { _Pragma("unroll") for (int m = 0; m < 4; ++m) _Pragma("unroll") for (int k = 0; k < 2; ++k) dst[m][k] = *(const PG8_LAS bf16x8*)(lds + PG8_SA(b, h) + aoff + m * 2048 + k * 1024); } while (0)
#define PG8_LDB(dst, b, h) do { _Pragma("unroll") for (int n = 0; n < 2; ++n) _Pragma("unroll") for (int k = 0; k < 2; ++k) dst[n][k] = *(const PG8_LAS bf16x8*)(lds + PG8_SB(b, h) + boff + n * 2048 + k * 1024); } while (0)
#define PG8_MMA(ai, bj, At, Bt) do { __builtin_amdgcn_s_setprio(1); _Pragma("unroll") for (int m = 0; m < 4; ++m) _Pragma("unroll") for (int n = 0; n < 2; ++n) _Pragma("unroll") for (int k = 0; k < 2; ++k) \
        acc[ai][bj][m][n] = __builtin_amdgcn_mfma_f32_16x16x32_bf16(Bt[n][k], At[m][k], acc[ai][bj][m][n], 0, 0, 0); __builtin_amdgcn_s_setprio(0); } while (0)
#define PG8_WAIT_V(n) asm volatile("s_waitcnt vmcnt(" #n ")" ::: "memory")
#define PG8_WAIT_L(n) asm volatile("s_waitcnt lgkmcnt(" #n ")" ::: "memory")
#define PG8_BAR __builtin_amdgcn_s_barrier()
#define PG8_SCHED __builtin_amdgcn_sched_barrier(0)
    Unit cur, nxt; int ui = 0;
    if (!S.next(0, cur)) return;
    f32x4 acc[2][2][4][2];
#pragma unroll
    for (int a = 0; a < 2; ++a)
#pragma unroll
        for (int b = 0; b < 2; ++b)
#pragma unroll
            for (int m = 0; m < 4; ++m)
#pragma unroll
                for (int n = 0; n < 2; ++n) acc[a][b][m][n] = (f32x4){0.f, 0.f, 0.f, 0.f};
    bf16x8 At[4][2], B0[2][2], B1[2][2];
    const char* cA = (const char*)g.A + (size_t)cur.g * g.gsA + (size_t)cur.pm * tsA; const char* cB = (const char*)g.Bt + (size_t)cur.g * g.gsB + (size_t)cur.pn * tsB;
    PG8_STAGE(PG8_SB(0, 0), cB, voffB); PG8_STAGE(PG8_SB(0, 1), cB + hsB, voffB); PG8_STAGE(PG8_SA(0, 0), cA, voffA); PG8_STAGE(PG8_SA(0, 1), cA + hsA, voffA);
    if (wr == 1) PG8_BAR;
    PG8_WAIT_V(2); PG8_BAR;
    PG8_STAGE(PG8_SB(1, 0), cB + kstep, voffB); PG8_STAGE(PG8_SA(1, 0), cA + kstep, voffA); PG8_STAGE(PG8_SB(1, 1), cB + hsB + kstep, voffB);
    PG8_WAIT_V(6); PG8_BAR;
    for (;;) {
        const bool has_next = S.next(ui + 1, nxt);
        const char* nA = has_next ? (const char*)g.A + (size_t)nxt.g * g.gsA + (size_t)nxt.pm * tsA : cA; const char* nB = has_next ? (const char*)g.Bt + (size_t)nxt.g * g.gsB + (size_t)nxt.pn * tsB : cB;
        for (int t = 0; t < nt; t += 2) {
            const bool last = (t == nt - 2);
            const char* a1 = cA + (size_t)(t + 1) * kstep;
            const char* a2 = last ? nA : cA + (size_t)(t + 2) * kstep; const char* b2 = last ? nB : cB + (size_t)(t + 2) * kstep;
            const char* a3 = a2 + kstep; const char* b3 = b2 + kstep;
            PG8_LDB(B0, 0, 0); PG8_LDB(B1, 0, 1); PG8_SCHED; PG8_LDA(At, 0, 0); PG8_STAGE(PG8_SA(1, 1), a1 + hsA, voffA);
            PG8_WAIT_V(8); PG8_WAIT_L(0); PG8_BAR; PG8_MMA(0, 0, At, B0); PG8_MMA(0, 1, At, B1); PG8_BAR; PG8_SCHED;
            PG8_LDA(At, 0, 1); PG8_STAGE(PG8_SB(0, 0), b2, voffB); PG8_STAGE(PG8_SB(0, 1), b2 + hsB, voffB); PG8_STAGE(PG8_SA(0, 0), a2, voffA);
            PG8_WAIT_V(8); PG8_WAIT_L(0); PG8_BAR; PG8_MMA(1, 0, At, B0); PG8_MMA(1, 1, At, B1); PG8_BAR; PG8_SCHED;
            PG8_LDB(B0, 1, 0); PG8_LDB(B1, 1, 1); PG8_SCHED; PG8_LDA(At, 1, 0); PG8_STAGE(PG8_SA(0, 1), a2 + hsA, voffA);
            PG8_WAIT_V(8); PG8_WAIT_L(0); PG8_BAR; PG8_MMA(0, 0, At, B0); PG8_MMA(0, 1, At, B1); PG8_BAR; PG8_SCHED;
            PG8_LDA(At, 1, 1); PG8_STAGE(PG8_SB(1, 0), b3, voffB); PG8_STAGE(PG8_SB(1, 1), b3 + hsB, voffB); PG8_STAGE(PG8_SA(1, 0), a3, voffA);
            PG8_WAIT_V(8); PG8_WAIT_L(0); PG8_BAR; PG8_MMA(1, 0, At, B0); PG8_MMA(1, 1, At, B1); PG8_BAR; PG8_SCHED;
        }
        if constexpr (ALIGN_EPI) { if (wr == 0) PG8_BAR; }
        E(acc, cur, wr, wc, fr, fq);
        if (!has_next) break;
#pragma unroll
        for (int a = 0; a < 2; ++a)
#pragma unroll
            for (int b = 0; b < 2; ++b)
#pragma unroll
                for (int m = 0; m < 4; ++m)
#pragma unroll
                    for (int n = 0; n < 2; ++n) acc[a][b][m][n] = (f32x4){0.f, 0.f, 0.f, 0.f};
        cur = nxt; cA = nA; cB = nB; ++ui;
        if constexpr (ALIGN_EPI) { if (wr == 1) PG8_BAR; }
    }
    PG8_WAIT_V(0);
    if constexpr (!ALIGN_EPI) { if (wr == 0) PG8_BAR; }
    PG8_BAR;
#undef PG8_SA
#undef PG8_SB
#undef PG8_STAGE
#undef PG8_LDA
#undef PG8_LDB
#undef PG8_MMA
#undef PG8_WAIT_V
#undef PG8_WAIT_L
#undef PG8_BAR
#undef PG8_SCHED
}
}

using pg8::f32x4; using pg8::u32x4; using pg8::u32x2; using pg8::bf16x8; using pg8::pack8; using pg8::unpack8; using pg8::cvt_pk_bf16;
typedef unsigned short bf16;
#define LAS __attribute__((address_space(3)))

constexpr int NB = 8, SEQ = 4096, D = 1024, FF = 4096, M = NB * SEQ;
constexpr int TCH = 32, NCH = SEQ / TCH;
constexpr int UK = TCH * 16 + 128;
constexpr float EPS = 1e-6f;

constexpr size_t MiB = 1u << 20;
constexpr size_t WS_MOD = 1 * MiB, WS_SHW = 2 * MiB, WS_ABT = 3 * MiB, WS_PART = 4 * MiB, WS_PARTV = 6 * MiB;
constexpr size_t WS_W1 = 8 * MiB, WS_W2 = 40 * MiB, WS_WCI = 72 * MiB, WS_WCO = 84 * MiB, WS_WSI = 88 * MiB, WS_WGLU = 90 * MiB, WS_WSO = 92 * MiB, WS_WGI = 94 * MiB, WS_WGO = 98 * MiB, WS_WST = 100 * MiB;
constexpr size_t WS_TOEP = 101 * MiB, WS_MST = 141 * MiB;
constexpr size_t WS_XA = 160 * MiB, WS_HID = 224 * MiB, WS_T0 = 224 * MiB, WS_T1 = 288 * MiB, WS_T2 = 352 * MiB, WS_T3 = 416 * MiB;
constexpr size_t WS_UEXT = WS_T0, WS_SEND = 304 * MiB, WS_END = 480 * MiB;
constexpr int LDS_BYTES = 147456;

struct Params { const float* in[30]; float* out; unsigned char* ws; };

__device__ __forceinline__ float wave_sum(float v) {
#pragma unroll
    for (int o = 1; o < 64; o <<= 1) v += __shfl_xor(v, o);
    return v;
}
__device__ __forceinline__ float sum4(f32x4 a) { return (a[0] + a[1]) + (a[2] + a[3]); }
__device__ __forceinline__ float dot4(f32x4 a) { return (a[0] * a[0] + a[1] * a[1]) + (a[2] * a[2] + a[3] * a[3]); }
__device__ __forceinline__ float row_rstd(const float* part, int row) {
    const f32x4* p = (const f32x4*)(part + (size_t)row * 16);
    const f32x4 a = p[0], b = p[1], c = p[2], d = p[3];
    const float s = (sum4(a) + sum4(b)) + (sum4(c) + sum4(d));
    return rsqrtf(s * (1.0f / 1024.0f) + EPS);
}
__device__ __forceinline__ float sigmoid_f(float x) { return __builtin_amdgcn_rcpf(1.0f + __builtin_amdgcn_exp2f(-1.4426950408889634f * x)); }
__device__ __forceinline__ float gelu_tanh_f(float y) { const float t = 0.7978845608028654f * (y + 0.044715f * y * y * y); return y * sigmoid_f(2.0f * t); }

template <int MODE  > struct EpiIn {
    const float* part; const float* shw; int N; bf16* O0; bf16* O1; float* partv;
    __device__ __forceinline__ void operator()(const f32x4 (&acc)[2][2][4][2], const pg8::Unit& u, int wr, int wc, int fr, int fq) const {
        const int row0 = u.pm * 256 + wr * 64 + fr, b = u.pm >> 4, colt = u.pn * 256 + wc * 32 + 8 * fq;
        f32x4 bv[2][2];
#pragma unroll
        for (int bj = 0; bj < 2; ++bj)
#pragma unroll
            for (int n = 0; n < 2; ++n) bv[bj][n] = *(const f32x4*)(shw + (size_t)b * N + colt + bj * 128 + 4 * n);
#pragma unroll
        for (int ai = 0; ai < 2; ++ai)
#pragma unroll
            for (int m = 0; m < 4; ++m) {
                const int row = row0 + ai * 128 + m * 16; const float rs = row_rstd(part, row);
                f32x4 v[2][2];
#pragma unroll
                for (int bj = 0; bj < 2; ++bj)
#pragma unroll
                    for (int n = 0; n < 2; ++n) v[bj][n] = acc[ai][bj][m][n] * rs + bv[bj][n];
                if (MODE == 0) {
                    if (u.pn < 4) {
#pragma unroll
                        for (int bj = 0; bj < 2; ++bj) *(u32x4*)(O0 + (size_t)row * D + colt + bj * 128) = pack8(v[bj][0], v[bj][1]);
                    } else {
                        *(u32x4*)(O1 + (size_t)row * D + (u.pn - 4) * 128 + wc * 32 + 8 * fq) = pack8(v[0][0] * v[1][0], v[0][1] * v[1][1]);
                    }
                } else if (MODE == 1) {
                    const int bb = row >> 12, l = row & 4095;
#pragma unroll
                    for (int bj = 0; bj < 2; ++bj) { const int col = colt + bj * 128, gg = col >> 4, h0 = col & 15;
                        *(u32x4*)(O0 + ((size_t)gg * 1024 + bb * NCH + (l >> 5)) * UK + (l & 31) * 16 + h0) = pack8(v[bj][0], v[bj][1]); }
                } else if (MODE == 2) {
                    if (u.pn < 4) {
#pragma unroll
                        for (int bj = 0; bj < 2; ++bj) *(u32x4*)(O0 + (size_t)row * D + colt + bj * 128) = pack8(v[bj][0], v[bj][1]);
                    } else {
                        float ss = (dot4(v[0][0]) + dot4(v[0][1])) + (dot4(v[1][0]) + dot4(v[1][1]));
#pragma unroll
                        for (int bj = 0; bj < 2; ++bj) *(u32x4*)(O1 + (size_t)row * D + (colt - 1024) + bj * 128) = pack8(v[bj][0], v[bj][1]);
                        ss += __shfl_xor(ss, 16); ss += __shfl_xor(ss, 32);
                        if (fq == 0) partv[(size_t)row * 16 + (u.pn - 4) * 4 + wc] = ss;
                    }
                } else {
#pragma unroll
                    for (int bj = 0; bj < 2; ++bj) {
                        f32x4 r0 = __builtin_elementwise_max(v[bj][0], (f32x4){0.f, 0.f, 0.f, 0.f}), r1 = __builtin_elementwise_max(v[bj][1], (f32x4){0.f, 0.f, 0.f, 0.f});
                        *(u32x4*)(O0 + (size_t)row * FF + colt + bj * 128) = pack8(r0 * r0, r1 * r1); }
                }
            }
    }
};
struct EpiRes {
    const float* xin; float* xout; const float* gate; const float* anext; bf16* xa; float* part;
    __device__ __forceinline__ void operator()(const f32x4 (&acc)[2][2][4][2], const pg8::Unit& u, int wr, int wc, int fr, int fq) const {
        const int row0 = u.pm * 256 + wr * 64 + fr, b = u.pm >> 4, colt = u.pn * 256 + wc * 32 + 8 * fq;
        f32x4 gv[2][2], av[2][2];
#pragma unroll
        for (int bj = 0; bj < 2; ++bj)
#pragma unroll
            for (int n = 0; n < 2; ++n) { gv[bj][n] = *(const f32x4*)(gate + b * D + colt + bj * 128 + 4 * n);
                av[bj][n] = anext ? *(const f32x4*)(anext + b * D + colt + bj * 128 + 4 * n) : (f32x4){0.f, 0.f, 0.f, 0.f}; }
#pragma unroll
        for (int ai = 0; ai < 2; ++ai)
#pragma unroll
            for (int m = 0; m < 4; ++m) {
                const int row = row0 + ai * 128 + m * 16; float ss = 0.f;
#pragma unroll
                for (int bj = 0; bj < 2; ++bj) { const size_t off = (size_t)row * D + colt + bj * 128;
                    f32x4 x0 = *(const f32x4*)(xin + off), x1 = *(const f32x4*)(xin + off + 4);
                    x0 = x0 + gv[bj][0] * acc[ai][bj][m][0]; x1 = x1 + gv[bj][1] * acc[ai][bj][m][1];
                    *(f32x4*)(xout + off) = x0; *(f32x4*)(xout + off + 4) = x1;
                    ss += dot4(x0) + dot4(x1);
                    if (anext) *(u32x4*)(xa + off) = pack8(x0 * av[bj][0], x1 * av[bj][1]); }
                ss += __shfl_xor(ss, 16); ss += __shfl_xor(ss, 32);
                if (fq == 0) part[(size_t)row * 16 + u.pn * 4 + wc] = ss;
            }
    }
};
struct EpiS1 {
    float* send;
    __device__ __forceinline__ void operator()(const f32x4 (&acc)[2][2][4][2], const pg8::Unit& u, int wr, int wc, int fr, int fq) const {
        const int row0 = u.pm * 256 + wr * 64 + fr;
#pragma unroll
        for (int ai = 0; ai < 2; ++ai)
#pragma unroll
            for (int m = 0; m < 4; ++m) { float* p = send + ((size_t)u.g * 1024 + row0 + ai * 128 + m * 16) * 128 + wc * 32 + 8 * fq;
                *(f32x4*)p = acc[ai][0][m][0]; *(f32x4*)(p + 4) = acc[ai][0][m][1]; }
    }
};
struct EpiS3 {
    const bf16* uext; const float* dskip; bf16* Y;
    __device__ __forceinline__ void operator()(const f32x4 (&acc)[2][2][4][2], const pg8::Unit& u, int wr, int wc, int fr, int fq) const {
        const int row0 = u.pm * 256 + wr * 64 + fr, colt = u.pn * 256 + wc * 32 + 8 * fq, h0 = colt & 15;
        const f32x4 d0 = *(const f32x4*)(dskip + u.g * 16 + h0), d1 = *(const f32x4*)(dskip + u.g * 16 + h0 + 4);
#pragma unroll
        for (int ai = 0; ai < 2; ++ai)
#pragma unroll
            for (int m = 0; m < 4; ++m) { const int row = row0 + ai * 128 + m * 16;
#pragma unroll
                for (int bj = 0; bj < 2; ++bj) { const int col = colt + bj * 128, t = col >> 4;
                    f32x4 u0, u1; unpack8(*(const u32x4*)(uext + ((size_t)u.g * 1024 + row) * UK + col), u0, u1);
                    f32x4 y0 = acc[ai][bj][m][0] + d0 * u0, y1 = acc[ai][bj][m][1] + d1 * u1;
#pragma unroll
                    for (int e = 0; e < 4; ++e) { y0[e] = gelu_tanh_f(y0[e]); y1[e] = gelu_tanh_f(y1[e]); }
                    *(u32x4*)(Y + ((size_t)row * TCH + t) * D + u.g * 16 + h0) = pack8(y0, y1); } }
    }
};
struct EpiGlu {
    const bf16* Y; const float* gb; bf16* Y2;
    __device__ __forceinline__ void operator()(const f32x4 (&acc)[2][2][4][2], const pg8::Unit& u, int wr, int wc, int fr, int fq) const {
        const int row0 = u.pm * 256 + wr * 64 + fr, colt = u.pn * 256 + wc * 32 + 8 * fq;
        f32x4 bv[2][2];
#pragma unroll
        for (int bj = 0; bj < 2; ++bj)
#pragma unroll
            for (int n = 0; n < 2; ++n) bv[bj][n] = *(const f32x4*)(gb + colt + bj * 128 + 4 * n);
#pragma unroll
        for (int ai = 0; ai < 2; ++ai)
#pragma unroll
            for (int m = 0; m < 4; ++m) { const int row = row0 + ai * 128 + m * 16;
#pragma unroll
                for (int bj = 0; bj < 2; ++bj) { const size_t off = (size_t)row * D + colt + bj * 128;
                    f32x4 y0, y1; unpack8(*(const u32x4*)(Y + off), y0, y1);
                    f32x4 z0 = acc[ai][bj][m][0] + bv[bj][0], z1 = acc[ai][bj][m][1] + bv[bj][1];
#pragma unroll
                    for (int e = 0; e < 4; ++e) { y0[e] *= sigmoid_f(z0[e]); y1[e] *= sigmoid_f(z1[e]); }
                    *(u32x4*)(Y2 + off) = pack8(y0, y1); } }
    }
};

__device__ __forceinline__ void transpose_item(const float* W, int K, int N, bf16* WT, int mode, LAS float* scr, int item, int lane) {
    const int nblk = N / 32, kb = item / nblk, nb = item % nblk, k0 = 64 * kb, n0 = 32 * nb;
    int drow = n0;
    if (mode == 1 && n0 >= 1024) { int nn = n0 - 1024; const int half = nn >> 10; nn &= 1023; drow = 1024 + 256 * (nn >> 7) + 128 * half + (nn & 127); }
#pragma unroll 8
    for (int i = 0; i < 32; ++i) { const int kk = 2 * i + (lane >> 5); scr[kk * 33 + (lane & 31)] = W[(size_t)(k0 + kk) * N + n0 + (lane & 31)]; }
    asm volatile("s_waitcnt lgkmcnt(0)" ::: "memory");
    const int c = lane & 7;
#pragma unroll
    for (int j = 0; j < 4; ++j) { const int n = (lane >> 3) + 8 * j; const LAS float* s = scr + (8 * c) * 33 + n;
        u32x4 o; o.x = cvt_pk_bf16(s[0 * 33], s[1 * 33]); o.y = cvt_pk_bf16(s[2 * 33], s[3 * 33]); o.z = cvt_pk_bf16(s[4 * 33], s[5 * 33]); o.w = cvt_pk_bf16(s[6 * 33], s[7 * 33]);
        *(u32x4*)(WT + (size_t)(drow + n) * K + k0 + 8 * c) = o; }
    asm volatile("s_waitcnt lgkmcnt(0)" ::: "memory");
}

__global__ void __launch_bounds__(512, 2) mk_fwd(Params P) {
    extern __shared__ __attribute__((aligned(16))) unsigned char lds_raw[];
    cg::grid_group grid = cg::this_grid();
    LAS unsigned char* lds = (LAS unsigned char*)lds_raw;
    const int bid = blockIdx.x, G = gridDim.x;
    const int vcu = (G % 8 == 0) ? (bid % 8) * (G / 8) + bid / 8 : bid;
    const int NGW = G * 8;
#define FRESH_TID() int tid = threadIdx.x; asm volatile("" : "+v"(tid)); const int lane = tid & 63, wave = __builtin_amdgcn_readfirstlane(tid >> 6); const int gw = bid * 8 + wave; (void)lane; (void)gw
    unsigned char* ws = P.ws;
    float* modv = (float*)(ws + WS_MOD); float* shw = (float*)(ws + WS_SHW); float* abt = (float*)(ws + WS_ABT);
    float* part = (float*)(ws + WS_PART); float* partv = (float*)(ws + WS_PARTV);
    bf16* W1t = (bf16*)(ws + WS_W1); bf16* W2t = (bf16*)(ws + WS_W2); bf16* Wci = (bf16*)(ws + WS_WCI); bf16* Wco = (bf16*)(ws + WS_WCO);
    bf16* Wsi = (bf16*)(ws + WS_WSI); bf16* Wglu = (bf16*)(ws + WS_WGLU); bf16* Wso = (bf16*)(ws + WS_WSO); bf16* Wgi = (bf16*)(ws + WS_WGI); bf16* Wgo = (bf16*)(ws + WS_WGO);
    bf16* WSt = (bf16*)(ws + WS_WST); bf16* Toep = (bf16*)(ws + WS_TOEP); bf16* Mst = (bf16*)(ws + WS_MST);
    bf16* XA = (bf16*)(ws + WS_XA); bf16* HID = (bf16*)(ws + WS_HID); bf16* T0 = (bf16*)(ws + WS_T0); bf16* T1 = (bf16*)(ws + WS_T1); bf16* T2 = (bf16*)(ws + WS_T2); bf16* T3 = (bf16*)(ws + WS_T3);
    bf16* UEXT = (bf16*)(ws + WS_UEXT); float* SEND = (float*)(ws + WS_SEND);
    float* X = P.out;

    {
    FRESH_TID();
    for (int it = bid; it < 96; it += G) {
        LAS float* cs = (LAS float*)lds; LAS float* red = cs + 8192;
        const float* c = P.in[1];
        for (int e = tid; e < 8192; e += 512) { const float v = c[e]; cs[e] = v / (1.0f + __expf(-v)); }
        __syncthreads();
        const int i = it / 24, n0 = (it % 24) * 256;
        const float* W = P.in[2] + (size_t)i * 1024 * 6144 + n0 + 4 * lane;
        f32x4 acc[8];
#pragma unroll
        for (int b = 0; b < 8; ++b) acc[b] = (f32x4){0.f, 0.f, 0.f, 0.f};
        const int k0 = wave * 128;
#pragma unroll 4
        for (int k = 0; k < 128; ++k) { const f32x4 w = *(const f32x4*)(W + (size_t)(k0 + k) * 6144);
#pragma unroll
            for (int b = 0; b < 8; ++b) acc[b] += cs[b * 1024 + k0 + k] * w; }
#pragma unroll
        for (int b = 0; b < 8; ++b) *(LAS f32x4*)(red + (wave * 8 + b) * 256 + 4 * lane) = acc[b];
        __syncthreads();
#pragma unroll
        for (int j = 0; j < 4; ++j) { const int o = tid + 512 * j, b = o >> 8, nn = o & 255, n = n0 + nn, kind = n >> 10, col = n & 1023;
            float s = P.in[3][i * 6144 + n];
#pragma unroll
            for (int w = 0; w < 8; ++w) s += red[(w * 8 + b) * 256 + nn];
            if (kind == 1) s = (1.0f + s) * P.in[4][i * 1024 + col];
            if (kind == 4) s = (1.0f + s) * P.in[5][i * 1024 + col];
            const int slot = kind == 0 ? 1 : kind == 1 ? 0 : kind == 2 ? 2 : kind == 3 ? 4 : kind == 4 ? 3 : 5;
            modv[((i * 6 + slot) * 8 + b) * 1024 + col] = s; }
        __syncthreads();
    }
    for (int it = bid; it < 256; it += G) {
        const int g = it >> 2, q = it & 3;
        LAS float* pw_re = (LAS float*)lds; LAS float* pw_im = pw_re + 33 * 65; LAS float* bb_re = pw_im + 33 * 65; LAS float* bb_im = bb_re + 1024;
        LAS float* cc_re = bb_im + 1024; LAS float* cc_im = cc_re + 16 * 65; LAS float* Kd = cc_im + 16 * 65;
        __syncthreads();
        if (tid < 64) { const int p = tid;
            const float dt = expf(P.in[16][g]); const float are = P.in[14][g * 64 + p], aim = P.in[15][g * 64 + p];
            const float mag = expf(are * dt); float sn, cs_; sincosf(aim * dt, &sn, &cs_);
            const float abr = mag * cs_, abi = mag * sn, den = are * are + aim * aim, nr = abr - 1.0f, ni = abi;
            const float fre = (nr * are + ni * aim) / den, fim = (ni * are - nr * aim) / den;
            float pr = 1.0f, pi = 0.0f;
            for (int d = 0; d <= 32; ++d) { pw_re[d * 65 + p] = pr; pw_im[d * 65 + p] = pi; const float npr = pr * abr - pi * abi, npi = pr * abi + pi * abr; pr = npr; pi = npi; }
            for (int h = 0; h < 16; ++h) { const float br = P.in[17][(g * 64 + p) * 16 + h], bi = P.in[18][(g * 64 + p) * 16 + h]; bb_re[p * 16 + h] = fre * br - fim * bi; bb_im[p * 16 + h] = fre * bi + fim * br; }
            if (q == 0) { abt[(g * 64 + p) * 2] = pw_re[32 * 65 + p]; abt[(g * 64 + p) * 2 + 1] = pw_im[32 * 65 + p]; }
        }
        for (int e = tid; e < 1024; e += 512) { const int h = e >> 6, p = e & 63; cc_re[h * 65 + p] = P.in[19][g * 1024 + e]; cc_im[h * 65 + p] = P.in[20][g * 1024 + e]; }
        __syncthreads();
        { const int d = tid >> 4, h = tid & 15; float s[16];
#pragma unroll
            for (int e = 0; e < 16; ++e) s[e] = 0.f;
            for (int p = 0; p < 64; ++p) { const float cr = cc_re[h * 65 + p], ci = cc_im[h * 65 + p], pr = pw_re[d * 65 + p], pi = pw_im[d * 65 + p];
                const float wre = cr * pr - ci * pi, wim = cr * pi + ci * pr;
#pragma unroll
                for (int e = 0; e < 16; ++e) s[e] += wre * bb_re[p * 16 + e] - wim * bb_im[p * 16 + e]; }
#pragma unroll
            for (int e = 0; e < 16; ++e) Kd[(d * 16 + h) * 16 + e] = s[e]; }
        __syncthreads();
        for (int v = tid; v < 10240; v += 512) { const int rr = v / 80, kv = v % 80, n = 128 * q + rr, t = n >> 4, h = n & 15, k0 = 8 * kv;
            float val[8];
            if (k0 < 512) { const int j = k0 >> 4, h0 = k0 & 15;
#pragma unroll
                for (int e = 0; e < 8; ++e) val[e] = (j <= t) ? Kd[((t - j) * 16 + h) * 16 + h0 + e] : 0.f;
            } else { const int p0 = (k0 - 512) >> 1;
#pragma unroll
                for (int pp = 0; pp < 4; ++pp) { const int p = p0 + pp; const float cr = cc_re[h * 65 + p], ci = cc_im[h * 65 + p], pr = pw_re[(t + 1) * 65 + p], pi = pw_im[(t + 1) * 65 + p];
                    val[2 * pp] = cr * pr - ci * pi; val[2 * pp + 1] = -(cr * pi + ci * pr); } }
            u32x4 o; o.x = cvt_pk_bf16(val[0], val[1]); o.y = cvt_pk_bf16(val[2], val[3]); o.z = cvt_pk_bf16(val[4], val[5]); o.w = cvt_pk_bf16(val[6], val[7]);
            *(u32x4*)(Toep + ((size_t)g * 512 + n) * UK + k0) = o; }
        for (int v = tid; v < 4096; v += 512) { const int rr = v >> 6, kv = v & 63, n = 64 * q + rr, k0 = 8 * kv, j = k0 >> 4, h0 = k0 & 15;
            float val[8];
            if (n < 128) { const int p = n >> 1, ri = n & 1, d = 31 - j; const float pr = pw_re[d * 65 + p], pi = pw_im[d * 65 + p];
#pragma unroll
                for (int e = 0; e < 8; ++e) { const float br = bb_re[p * 16 + h0 + e], bi = bb_im[p * 16 + h0 + e]; val[e] = ri == 0 ? (pr * br - pi * bi) : (pr * bi + pi * br); }
            } else {
#pragma unroll
                for (int e = 0; e < 8; ++e) val[e] = 0.f; }
            u32x4 o; o.x = cvt_pk_bf16(val[0], val[1]); o.y = cvt_pk_bf16(val[2], val[3]); o.z = cvt_pk_bf16(val[4], val[5]); o.w = cvt_pk_bf16(val[6], val[7]);
            *(u32x4*)(Mst + ((size_t)g * 256 + n) * 512 + k0) = o; }
        __syncthreads();
    }
    for (int e = bid * 512 + tid; e < 8 * 128 * 128; e += G * 512) { const int t = (e >> 7) & 127, s = e & 127; WSt[e] = (s <= t) ? (bf16)(cvt_pk_bf16(P.in[27][e], 0.f) & 0xffffu) : (bf16)0; }
    {
        LAS float* scr = (LAS float*)(lds + wave * 8704);
        __syncthreads();
        for (int it = gw; it < 23552; it += NGW) {
            int r = it;
            if (r < 8192) { const int mt = r >> 11; transpose_item(P.in[6] + (size_t)mt * D * FF, D, FF, W1t + (size_t)mt * D * FF, 0, scr, r & 2047, lane); continue; } r -= 8192;
            if (r < 8192) { const int mt = r >> 11; transpose_item(P.in[7] + (size_t)mt * D * FF, FF, D, W2t + (size_t)mt * D * FF, 0, scr, r & 2047, lane); continue; } r -= 8192;
            if (r < 3072) { const int mt = r / 1536; transpose_item(P.in[9] + (size_t)mt * D * 3072, D, 3072, Wci + (size_t)mt * D * 3072, 1, scr, r % 1536, lane); continue; } r -= 3072;
            if (r < 1024) { const int mt = r >> 9; transpose_item(P.in[12] + (size_t)mt * D * D, D, D, Wco + (size_t)mt * D * D, 0, scr, r & 511, lane); continue; } r -= 1024;
            if (r < 512) { transpose_item(P.in[13], D, D, Wsi, 0, scr, r, lane); continue; } r -= 512;
            if (r < 512) { transpose_item(P.in[22], D, D, Wglu, 0, scr, r, lane); continue; } r -= 512;
            if (r < 512) { transpose_item(P.in[24], D, D, Wso, 0, scr, r, lane); continue; } r -= 512;
            if (r < 1024) { transpose_item(P.in[25], D, 2048, Wgi, 0, scr, r, lane); continue; } r -= 1024;
            transpose_item(P.in[29], D, D, Wgo, 0, scr, r, lane);
        }
    }
    }
    grid.sync();

    {
    FRESH_TID();
    for (int r = gw; r < 25600; r += NGW) {
        int start, N, layer, slot; const bf16* Wt;
        if (r < 3072) { start = 0; N = 3072; Wt = Wci; layer = 0; slot = 1; }
        else if (r < 7168) { start = 3072; N = 4096; Wt = W1t; layer = 0; slot = 4; }
        else if (r < 8192) { start = 7168; N = 1024; Wt = Wsi; layer = 1; slot = 1; }
        else if (r < 12288) { start = 8192; N = 4096; Wt = W1t + (size_t)1 * D * FF; layer = 1; slot = 4; }
        else if (r < 14336) { start = 12288; N = 2048; Wt = Wgi; layer = 2; slot = 1; }
        else if (r < 18432) { start = 14336; N = 4096; Wt = W1t + (size_t)2 * D * FF; layer = 2; slot = 4; }
        else if (r < 21504) { start = 18432; N = 3072; Wt = Wci + (size_t)D * 3072; layer = 3; slot = 1; }
        else { start = 21504; N = 4096; Wt = W1t + (size_t)3 * D * FF; layer = 3; slot = 4; }
        const int n = r - start;
        f32x4 w0, w1, w2, w3; unpack8(*(const u32x4*)(Wt + (size_t)n * D + 8 * lane), w0, w1); unpack8(*(const u32x4*)(Wt + (size_t)n * D + 512 + 8 * lane), w2, w3);
        const float* sh = modv + (size_t)((layer * 6 + slot) * 8) * 1024;
#pragma unroll
        for (int b = 0; b < 8; ++b) { const f32x4* p0 = (const f32x4*)(sh + b * 1024 + 8 * lane); const f32x4* p1 = (const f32x4*)(sh + b * 1024 + 512 + 8 * lane);
            const f32x4 t = p0[0] * w0 + p0[1] * w1 + p1[0] * w2 + p1[1] * w3;
            const float s = wave_sum(sum4(t));
            if (lane == 0) shw[(size_t)8 * start + (size_t)b * N + n] = s; }
    }
    for (int m = gw; m < M; m += NGW) {
        const f32x4* xr = (const f32x4*)(P.in[0] + (size_t)m * D) + lane; const f32x4* ar = (const f32x4*)(modv + (size_t)(m >> 12) * 1024) + lane;
        f32x4 v[4]; float s = 0.f;
#pragma unroll
        for (int j = 0; j < 4; ++j) { v[j] = xr[64 * j]; s += dot4(v[j]); }
        s = wave_sum(s);
#pragma unroll
        for (int j = 0; j < 4; ++j) { const f32x4 o = v[j] * ar[64 * j]; u32x2 w; w.x = cvt_pk_bf16(o[0], o[1]); w.y = cvt_pk_bf16(o[2], o[3]); *((u32x2*)(XA + (size_t)m * D) + lane + 64 * j) = w; }
        if (lane < 16) part[(size_t)m * 16 + lane] = (lane == 0) ? s : 0.f;
    }
    }
    grid.sync();

#pragma unroll 1
    for (int li = 0; li < 4; ++li) {
        FRESH_TID();
        const int kind = li % 3, jm = li / 3;
        const float* mv = modv + (size_t)li * 6 * 8192;
        const int mstart = li == 0 ? 0 : li == 1 ? 7168 : li == 2 ? 12288 : 18432;
        const int fstart = li == 0 ? 3072 : li == 1 ? 8192 : li == 2 ? 14336 : 21504;
        const bf16* wout_t; const bf16* aout;
        if (kind == 0) {
            {   pg8::Gemm g{XA, Wci + (size_t)jm * D * 3072, D, D, D, 0, 0}; pg8::StaticOrder S; S.init(M, 3072, G, bid);
                EpiIn<0> E{part, shw + (size_t)8 * mstart, 3072, T0, T1, nullptr};
                pg8::gemm_phase<EpiIn<0>, pg8::StaticOrder, true>(lds, g, S, E); }
            grid.sync();
            {
                const float* cw = P.in[10] + (size_t)jm * 3 * D; const float* cb = P.in[11] + (size_t)jm * D;
                for (int run = bid * 4 + (tid >> 7); run < M / 32; run += G * 4) {
                    const int tok0 = run * 32, col = (tid & 127) * 8;
                    f32x4 c0a = *(const f32x4*)(cw + col), c0b = *(const f32x4*)(cw + col + 4), c1a = *(const f32x4*)(cw + D + col), c1b = *(const f32x4*)(cw + D + col + 4);
                    f32x4 c2a = *(const f32x4*)(cw + 2 * D + col), c2b = *(const f32x4*)(cw + 2 * D + col + 4), cba = *(const f32x4*)(cb + col), cbb = *(const f32x4*)(cb + col + 4);
                    f32x4 z1a = {0.f, 0.f, 0.f, 0.f}, z1b = z1a, z2a = z1a, z2b = z1a;
                    if ((tok0 & (SEQ - 1)) != 0) { unpack8(*(const u32x4*)(T1 + (size_t)(tok0 - 1) * D + col), z1a, z1b); unpack8(*(const u32x4*)(T1 + (size_t)(tok0 - 2) * D + col), z2a, z2b); }
#pragma unroll 4
                    for (int t = 0; t < 32; ++t) { const size_t off = (size_t)(tok0 + t) * D + col;
                        f32x4 za, zb, ba, bb; unpack8(*(const u32x4*)(T1 + off), za, zb); unpack8(*(const u32x4*)(T0 + off), ba, bb);
                        const f32x4 oa = ba * (c0a * z2a + c1a * z1a + c2a * za + cba), ob = bb * (c0b * z2b + c1b * z1b + c2b * zb + cbb);
                        *(u32x4*)(T2 + off) = pack8(oa, ob);
                        z2a = z1a; z2b = z1b; z1a = za; z1b = zb; }
                }
            }
            grid.sync();
            wout_t = Wco + (size_t)jm * D * D; aout = T2;
        } else if (kind == 1) {
            {   pg8::Gemm g{XA, Wsi, D, D, D, 0, 0}; pg8::StaticOrder S; S.init(M, D, G, bid);
                EpiIn<1> E{part, shw + (size_t)8 * mstart, D, UEXT, nullptr, nullptr};
                pg8::gemm_phase<EpiIn<1>, pg8::StaticOrder, true>(lds, g, S, E); }
            grid.sync();
            {   pg8::Gemm g{UEXT, Mst, 512, UK, 512, (size_t)1024 * UK * 2, (size_t)256 * 512 * 2}; pg8::GroupOrder S; S.init(4, 1, 64, G, vcu);
                EpiS1 E{SEND};
                pg8::gemm_phase<EpiS1, pg8::GroupOrder, true>(lds, g, S, E); }
            grid.sync();
            for (int wg = wave * G + bid; wg < 512; wg += 8 * G) { const int b = wg & 7, g = wg >> 3, p = lane;
                const float ar = abt[(g * 64 + p) * 2], ai = abt[(g * 64 + p) * 2 + 1];
                const float* se = SEND + ((size_t)g * 1024 + b * NCH) * 128 + 2 * p;
                bf16* so = UEXT + ((size_t)g * 1024 + b * NCH) * UK + 512 + 2 * p;
                float sr = 0.f, si = 0.f;
                *(unsigned*)so = 0u;
                for (int c0 = 0; c0 < NCH; c0 += 16) { float er[16], ei[16];
#pragma unroll
                    for (int j = 0; j < 16; ++j) { const float2 e = *(const float2*)(se + (size_t)(c0 + j) * 128); er[j] = e.x; ei[j] = e.y; }
#pragma unroll
                    for (int j = 0; j < 16; ++j) { const float nr = ar * sr - ai * si + er[j], ni = ar * si + ai * sr + ei[j]; sr = nr; si = ni;
                        if (c0 + j + 1 < NCH) *(unsigned*)(so + (size_t)(c0 + j + 1) * UK) = cvt_pk_bf16(sr, si); } }
            }
            grid.sync();
            {   pg8::Gemm g{UEXT, Toep, UK, UK, UK, (size_t)1024 * UK * 2, (size_t)512 * UK * 2}; pg8::GroupOrder S; S.init(4, 2, 64, G, vcu);
                EpiS3 E{UEXT, P.in[21], T2};
                pg8::gemm_phase<EpiS3, pg8::GroupOrder, true>(lds, g, S, E); }
            grid.sync();
            {   pg8::Gemm g{T2, Wglu, D, D, D, 0, 0}; pg8::StaticOrder S; S.init(M, D, G, bid);
                EpiGlu E{T2, P.in[23], T3};
                pg8::gemm_phase<EpiGlu, pg8::StaticOrder, true>(lds, g, S, E); }
            grid.sync();
            wout_t = Wso; aout = T3;
        } else {
            {   pg8::Gemm g{XA, Wgi, D, D, D, 0, 0}; pg8::StaticOrder S; S.init(M, 2048, G, bid);
                EpiIn<2> E{part, shw + (size_t)8 * mstart, 2048, T0, T1, partv};
                pg8::gemm_phase<EpiIn<2>, pg8::StaticOrder, true>(lds, g, S, E); }
            grid.sync();
            for (int cn = bid; cn < M / 128; cn += G) {
                LAS float* rstd_s = (LAS float*)lds; LAS bf16* wsA = (LAS bf16*)(lds + 1024); LAS bf16* vT = wsA + 128 * 136;
                const int wr = wave >> 1, wc = wave & 1, fr = lane & 15, fq = lane >> 4;
                __syncthreads();
                if (tid < 128) rstd_s[tid] = row_rstd(partv, cn * 128 + tid);
                __syncthreads();
                for (int hd = 0; hd < 8; ++hd) {
#pragma unroll
                    for (int j = 0; j < 4; ++j) { const int ch = tid + 512 * j, r = ch >> 4, c8 = (ch & 15) * 8;
                        *(LAS u32x4*)(wsA + r * 136 + c8) = *(const u32x4*)(WSt + hd * 16384 + r * 128 + c8);
                        f32x4 va, vb; unpack8(*(const u32x4*)(T1 + (size_t)(cn * 128 + r) * D + hd * 128 + c8), va, vb);
                        const float rs = rstd_s[r]; const f32x4 ga = *(const f32x4*)(P.in[26] + hd * 128 + c8), gb = *(const f32x4*)(P.in[26] + hd * 128 + c8 + 4);
                        va = va * rs * ga; vb = vb * rs * gb;
#pragma unroll
                        for (int e = 0; e < 4; ++e) { vT[(c8 + e) * 136 + r] = (bf16)(cvt_pk_bf16(va[e], 0.f) & 0xffffu); vT[(c8 + 4 + e) * 136 + r] = (bf16)(cvt_pk_bf16(vb[e], 0.f) & 0xffffu); } }
                    __syncthreads();
                    f32x4 acc[2][4];
#pragma unroll
                    for (int mi = 0; mi < 2; ++mi)
#pragma unroll
                        for (int ni = 0; ni < 4; ++ni) acc[mi][ni] = (f32x4){0.f, 0.f, 0.f, 0.f};
                    for (int ks = 0; ks <= wr; ++ks) { bf16x8 a[2], bfr[4];
#pragma unroll
                        for (int mi = 0; mi < 2; ++mi) a[mi] = *(const LAS bf16x8*)(wsA + (32 * wr + 16 * mi + fr) * 136 + 32 * ks + 8 * fq);
#pragma unroll
                        for (int ni = 0; ni < 4; ++ni) bfr[ni] = *(const LAS bf16x8*)(vT + (64 * wc + 16 * ni + fr) * 136 + 32 * ks + 8 * fq);
#pragma unroll
                        for (int mi = 0; mi < 2; ++mi)
#pragma unroll
                            for (int ni = 0; ni < 4; ++ni) acc[mi][ni] = __builtin_amdgcn_mfma_f32_16x16x32_bf16(bfr[ni], a[mi], acc[mi][ni], 0, 0, 0); }
#pragma unroll
                    for (int mi = 0; mi < 2; ++mi) { const int t = 32 * wr + 16 * mi + fr; const float bs = P.in[28][hd * 128 + t];
#pragma unroll
                        for (int ni = 0; ni < 4; ++ni) { const size_t off = (size_t)(cn * 128 + t) * D + hd * 128 + 64 * wc + 16 * ni + 4 * fq;
                            const u32x2 uw = *(const u32x2*)(T0 + off);
                            f32x4 uu; uu[0] = __uint_as_float(uw.x << 16); uu[1] = __uint_as_float(uw.x & 0xffff0000u); uu[2] = __uint_as_float(uw.y << 16); uu[3] = __uint_as_float(uw.y & 0xffff0000u);
                            const f32x4 o = uu * (acc[mi][ni] + bs); u32x2 w; w.x = cvt_pk_bf16(o[0], o[1]); w.y = cvt_pk_bf16(o[2], o[3]);
                            *(u32x2*)(T2 + off) = w; } }
                    __syncthreads();
                }
            }
            grid.sync();
            wout_t = Wgo; aout = T2;
        }
#pragma unroll 1
        for (int half = 0; half < 2; ++half) {
            if (half == 1) {
                pg8::Gemm g{XA, W1t + (size_t)li * D * FF, D, D, D, 0, 0}; pg8::StaticOrder S; S.init(M, FF, G, bid);
                EpiIn<3> E{part, shw + (size_t)8 * fstart, FF, HID, nullptr, nullptr};
                pg8::gemm_phase<EpiIn<3>, pg8::StaticOrder, true>(lds, g, S, E);
                grid.sync();
            }
            pg8::Gemm g; g.gsA = 0; g.gsB = 0;
            if (half == 0) { g.A = aout; g.Bt = wout_t; g.K = D; g.lda = D; g.ldb = D; }
            else { g.A = HID; g.Bt = W2t + (size_t)li * D * FF; g.K = FF; g.lda = FF; g.ldb = FF; }
            pg8::StaticOrder S; S.init(M, D, G, bid);
            EpiRes E; E.xin = (li == 0 && half == 0) ? P.in[0] : X; E.xout = X; E.gate = mv + (half == 0 ? 2 : 5) * 8192;
            E.anext = half == 0 ? mv + 3 * 8192 : (li < 3 ? modv + (size_t)(li + 1) * 6 * 8192 : nullptr); E.xa = XA; E.part = part;
            pg8::gemm_phase<EpiRes, pg8::StaticOrder, true>(lds, g, S, E);
            grid.sync();
        }
    }
    FRESH_TID();
    for (int m = gw; m < M; m += NGW) {
        f32x4* xr = (f32x4*)(X + (size_t)m * D) + lane; const f32x4* gr = (const f32x4*)P.in[8] + lane;
        f32x4 v[4]; float s = 0.f;
#pragma unroll
        for (int j = 0; j < 4; ++j) { v[j] = xr[64 * j]; s += dot4(v[j]); }
        const float rs = rsqrtf(wave_sum(s) * (1.0f / 1024.0f) + EPS);
#pragma unroll
        for (int j = 0; j < 4; ++j) xr[64 * j] = v[j] * rs * gr[64 * j];
    }
}

extern "C" void kernel_launch(void* const* d_in, const int* in_sizes, int n_in, void* d_out, int out_size, void* d_ws, size_t ws_size, hipStream_t stream) {
    static int grid = 0;
    if (grid == 0) {
        if (n_in != 30 || out_size != M * D || ws_size < WS_END) { fprintf(stderr, "kernel_launch: unexpected problem (n_in %d, out %d, ws %zu)\n", n_in, out_size, ws_size); grid = -1; return; }
        int dev = 0, cus = 0, per_cu = 0;
        hipGetDevice(&dev); hipDeviceGetAttribute(&cus, hipDeviceAttributeMultiprocessorCount, dev);
        if (hipFuncSetAttribute((const void*)mk_fwd, hipFuncAttributeMaxDynamicSharedMemorySize, LDS_BYTES) != hipSuccess) fprintf(stderr, "kernel_launch: hipFuncSetAttribute failed\n");
        if (hipOccupancyMaxActiveBlocksPerMultiprocessor(&per_cu, (const void*)mk_fwd, 512, LDS_BYTES) != hipSuccess || per_cu < 1) per_cu = 1;
        (void)hipGetLastError();
        grid = cus * per_cu; if (grid > 256) grid = 256; if (grid < 1) grid = 256;
    }
    if (grid < 0) return;
    Params p{};
    for (int i = 0; i < 30; ++i) p.in[i] = (const float*)d_in[i];
    p.out = (float*)d_out; p.ws = (unsigned char*)d_ws;
    void* args[] = {&p};
    hipError_t e = hipLaunchCooperativeKernel((const void*)mk_fwd, dim3(grid), dim3(512), args, LDS_BYTES, stream);
    if (e != hipSuccess) fprintf(stderr, "cooperative launch failed: %s (grid %d)\n", hipGetErrorString(e), grid);
}
```

```cpp
#include <hip/hip_runtime.h>
#include <hip/hip_cooperative_groups.h>
#include <cstdio>
#include <cstdint>
namespace cg = cooperative_groups;

namespace pg8 {
#define PG8_LAS __attribute__((address_space(3)))
typedef unsigned short bf16_t;
typedef short bf16x8 __attribute__((ext_vector_type(8)));
typedef float f32x4 __attribute__((ext_vector_type(4)));
typedef unsigned u32x4 __attribute__((ext_vector_type(4)));
typedef unsigned u32x2 __attribute__((ext_vector_type(2)));
constexpr int BM = 256, BK = 64, HALF = 128, HTB = HALF * BK * 2, STAGE_BYTES = 8 * HTB, NXCD = 8, WGM = 8;

__host__ __device__ __forceinline__ int lds_byte(int r, int c) { const int st = (r >> 4) * 2 + (c >> 5), rr = r & 15, cc = c & 31, ob = rr * 64 + cc * 2; return st * 1024 + (ob ^ (((ob >> 9) & 1) << 5)); }
__host__ __device__ __forceinline__ void stage_rc(int b, int& R, int& C) { const int st = b / 1024, sb = b % 1024, swz = sb ^ (((sb >> 9) & 1) << 5); R = (st >> 1) * 16 + swz / 64; C = (st & 1) * 32 + (swz % 64) / 2; }
__host__ __device__ __forceinline__ int perm32(int rho) { const int n = rho >> 4, i = rho & 15; return 8 * (i >> 2) + 4 * n + (i & 3); }

struct Unit { int pm, pn, g; };
struct Gemm { const bf16_t* A; const bf16_t* Bt; int K, lda, ldb; size_t gsA, gsB; };

struct StaticOrder {
    int nM, nN, nwg, G, c;
    __device__ void init(int M, int N, int G_, int c_) { nM = M / BM; nN = N / BM; nwg = nM * nN; G = G_; c = c_; }
    __device__ bool next(int i, Unit& u) const {
        const long L = (long)i * G + c; if (L >= nwg) return false;
        int wgid = (int)L; { const int q = nwg / NXCD, r = nwg % NXCD, xcd = wgid % NXCD, off = wgid / NXCD; wgid = (xcd < r ? xcd * (q + 1) : r * (q + 1) + (xcd - r) * q) + off; }
        const int nig = WGM * nN, gid = wgid / nig, fm = gid * WGM, gsz = (nM - fm) < WGM ? (nM - fm) : WGM;
        u.pm = fm + ((wgid % nig) % gsz); u.pn = (wgid % nig) / gsz; u.g = 0; return true;
    }
};
struct GroupOrder {
    int nM, upg, total, G, c;
    __device__ void init(int nM_, int nN_, int ngroups, int G_, int c_) { nM = nM_; upg = nM_ * nN_; total = upg * ngroups; G = G_; c = c_; }
    __device__ bool next(int i, Unit& u) const {
        const long L = (long)i * G + c; if (L >= total) return false;
        const int l = (int)L; u.g = l / upg; const int w = l % upg; u.pm = w % nM; u.pn = w / nM; return true;
    }
};

__device__ __forceinline__ unsigned cvt_pk_bf16(float lo, float hi) { unsigned r; asm volatile("v_cvt_pk_bf16_f32 %0, %1, %2" : "=v"(r) : "v"(lo), "v"(hi)); return r; }
__device__ __forceinline__ u32x4 pack8(f32x4 a, f32x4 b) { u32x4 w; w.x = cvt_pk_bf16(a[0], a[1]); w.y = cvt_pk_bf16(a[2], a[3]); w.z = cvt_pk_bf16(b[0], b[1]); w.w = cvt_pk_bf16(b[2], b[3]); return w; }
__device__ __forceinline__ void unpack8(u32x4 w, f32x4& a, f32x4& b) {
    a[0] = __uint_as_float(w.x << 16); a[1] = __uint_as_float(w.x & 0xffff0000u); a[2] = __uint_as_float(w.y << 16); a[3] = __uint_as_float(w.y & 0xffff0000u);
    b[0] = __uint_as_float(w.z << 16); b[1] = __uint_as_float(w.z & 0xffff0000u); b[2] = __uint_as_float(w.w << 16); b[3] = __uint_as_float(w.w & 0xffff0000u); }

template <class Epi, class Sched, bool ALIGN_EPI>
__device__ __forceinline__ void gemm_phase(PG8_LAS unsigned char* lds, const Gemm g, const Sched& S, const Epi& E) {
    int tid_ = threadIdx.x; asm volatile("" : "+v"(tid_));
    const int tid = tid_, wid = __builtin_amdgcn_readfirstlane(tid >> 6), lane = tid & 63, wr = wid >> 2, wc = wid & 3, fr = lane & 15, fq = lane >> 4;
    const int K = g.K, nt = K / BK;
    unsigned voffA[2], voffB[2];
#pragma unroll
    for (int i = 0; i < 2; ++i) { int R, C; stage_rc(tid * 16 + i * 8192, R, C); const int Rb = (R & ~31) + perm32(R & 31);
        voffA[i] = (unsigned)(R * g.lda + C) * 2u; voffB[i] = (unsigned)(Rb * g.ldb + C) * 2u; }
    const size_t kstep = (size_t)(BK * 2);
    const size_t hsA = (size_t)HALF * g.lda * 2, hsB = (size_t)HALF * g.ldb * 2;
    const size_t tsA = 2 * hsA, tsB = 2 * hsB;
    const unsigned ldsw = (unsigned)wid * 1024u;
    const int aoff = lds_byte(wr * 64 + fr, fq * 8), boff = lds_byte(wc * 32 + fr, fq * 8);
#define PG8_SA(b, h) (((b) * 2 + (h)) * HTB)
#define PG8_SB(b, h) ((4 + (b) * 2 + (h)) * HTB)
#define PG8_STAGE(bufoff, gbase, voff) do { _Pragma("unroll") for (int _i = 0; _i < 2; ++_i) \
        __builtin_amdgcn_global_load_lds((const unsigned*)((const char*)(gbase) + (voff)[_i]), (PG8_LAS unsigned*)(lds + (bufoff) + ldsw + _i * 8192), 16, 0, 0); } while (0)
#define PG8_LDA(dst, b, h) do { _Pragma("unroll") for (int m = 0; m < 4; ++m) _Pragma("unroll") for (int k = 0; k < 2; ++k) dst[m][k] = *(const PG8_LAS bf16x8*)(lds + PG8_SA(b, h) + aoff + m * 2048 + k * 1024); } while (0)
#define PG8_LDB(dst, b, h) do { _Pragma("unroll") for (int n = 0; n < 2; ++n) _Pragma("unroll") for (int k = 0; k < 2; ++k) dst[n][k] = *(const PG8_LAS bf16x8*)(lds + PG8_SB(b, h) + boff + n * 2048 + k * 1024); } while (0)
#define PG8_MMA(ai, bj, At, Bt) do { __builtin_amdgcn_s_setprio(1); _Pragma("unroll") for (int m = 0; m < 4; ++m) _Pragma("unroll") for (int n = 0; n < 2; ++n) _Pragma("unroll") for (int k = 0; k < 2; ++k) \
        acc[ai][bj][m][n] = __builtin_amdgcn_mfma_f32_16x16x32_bf16(Bt[n][k], At[m][k], acc[ai][bj][m][n], 0, 0, 0); __builtin_amdgcn_s_setprio(0); } while (0)
#define PG8_WAIT_V(n) asm volatile("s_waitcnt vmcnt(" #n ")" ::: "memory")
#define PG8_WAIT_L(n) asm volatile("s_waitcnt lgkmcnt(" #n ")" ::: "memory")
#define PG8_BAR __builtin_amdgcn_s_barrier()
#define PG8_SCHED __builtin_amdgcn_sched_barrier(0)
    Unit cur, nxt; int ui = 0;
    if (!S.next(0, cur)) return;
    f32x4 acc[2][2][4][2];
#pragma unroll
    for (int a = 0; a < 2; ++a)
#pragma unroll
        for (int b = 0; b < 2; ++b)
#pragma unroll
            for (int m = 0; m < 4; ++m)
#pragma unroll
                for (int n = 0; n < 2; ++n) acc[a][b][m][n] = (f32x4){0.f, 0.f, 0.f, 0.f};
    bf16x8 At[4][2], B0[2][2], B1[2][2];
    const char* cA = (const char*)g.A + (size_t)cur.g * g.gsA + (size_t)cur.pm * tsA; const char* cB = (const char*)g.Bt + (size_t)cur.g * g.gsB + (size_t)cur.pn * tsB;
    PG8_STAGE(PG8_SB(0, 0), cB, voffB); PG8_STAGE(PG8_SB(0, 1), cB + hsB, voffB); PG8_STAGE(PG8_SA(0, 0), cA, voffA); PG8_STAGE(PG8_SA(0, 1), cA + hsA, voffA);
    if (wr == 1) PG8_BAR;
    PG8_WAIT_V(2); PG8_BAR;
    PG8_STAGE(PG8_SB(1, 0), cB + kstep, voffB); PG8_STAGE(PG8_SA(1, 0), cA + kstep, voffA); PG8_STAGE(PG8_SB(1, 1), cB + hsB + kstep, voffB);
    PG8_WAIT_V(6); PG8_BAR;
    for (;;) {
        const bool has_next = S.next(ui + 1, nxt);
        const char* nA = has_next ? (const char*)g.A + (size_t)nxt.g * g.gsA + (size_t)nxt.pm * tsA : cA; const char* nB = has_next ? (const char*)g.Bt + (size_t)nxt.g * g.gsB + (size_t)nxt.pn * tsB : cB;
        for (int t = 0; t < nt; t += 2) {
            const bool last = (t == nt - 2);
            const char* a1 = cA + (size_t)(t + 1) * kstep;
            const char* a2 = last ? nA : cA + (size_t)(t + 2) * kstep; const char* b2 = last ? nB : cB + (size_t)(t + 2) * kstep;
            const char* a3 = a2 + kstep; const char* b3 = b2 + kstep;
            PG8_LDB(B0, 0, 0); PG8_LDB(B1, 0, 1); PG8_SCHED; PG8_LDA(At, 0, 0); PG8_STAGE(PG8_SA(1, 1), a1 + hsA, voffA);
            PG8_WAIT_V(8); PG8_WAIT_L(0); PG8_BAR; PG8_MMA(0, 0, At, B0); PG8_MMA(0, 1, At, B1); PG8_BAR; PG8_SCHED;
            PG8_LDA(At, 0, 1); PG8_STAGE(PG8_SB(0, 0), b2, voffB); PG8_STAGE(PG8_SB(0, 1), b2 + hsB, voffB); PG8_STAGE(PG8_SA(0, 0), a2, voffA);
            PG8_WAIT_V(8); PG8_WAIT_L(0); PG8_BAR; PG8_MMA(1, 0, At, B0); PG8_MMA(1, 1, At, B1); PG8_BAR; PG8_SCHED;
            PG8_LDB(B0, 1, 0); PG8_LDB(B1, 1, 1); PG8_SCHED; PG8_LDA(At, 1, 0); PG8_STAGE(PG8_SA(0, 1), a2 + hsA, voffA);
            PG8_WAIT_V(8); PG8_WAIT_L(0); PG8_BAR; PG8_MMA(0, 0, At, B0); PG8_MMA(0, 1, At, B1); PG8_BAR; PG8_SCHED;
            PG8_LDA(At, 1, 1); PG8_STAGE(PG8_SB(1, 0), b3, voffB); PG8_STAGE(PG8_SB(1, 1), b3 + hsB, voffB); PG8_STAGE(PG8_SA(1, 0), a3, voffA);
            PG8_WAIT_V(8); PG8_WAIT_L(0); PG8_BAR; PG8_MMA(1, 0, At, B0); PG8_MMA(1, 1, At, B1); PG8_BAR; PG8_SCHED;
        }
        if constexpr (ALIGN_EPI) { if (wr == 0) PG8_BAR; }
        E(acc, cur, wr, wc, fr, fq);
        if (!has_next) break;
#pragma unroll
        for (int a = 0; a < 2; ++a)
#pragma unroll
            for (int b = 0; b < 2; ++b)
#pragma unroll
                for (int m = 0; m < 4; ++m)
#pragma unroll
                    for (int n = 0; n < 2; ++n) acc[a][b][m][n] = (f32x4){0.f, 0.f, 0.f, 0.f};
        cur = nxt; cA = nA; cB = nB; ++ui;
        if constexpr (ALIGN_EPI) { if (wr == 1) PG8_BAR; }
    }
    PG8_WAIT_V(0);
    if constexpr (!ALIGN_EPI) { if (wr == 0) PG8_BAR; }
    PG8_BAR;
#undef PG8_SA
#undef PG8_SB
#undef PG8_STAGE
#undef PG8_LDA
#undef PG8_LDB
#undef PG8_MMA
#undef PG8_WAIT_V
#undef PG8_WAIT_L
#undef PG8_BAR
#undef PG8_SCHED
}
}

using pg8::f32x4; using pg8::u32x4; using pg8::u32x2; using pg8::bf16x8; using pg8::pack8; using pg8::unpack8; using pg8::cvt_pk_bf16;
typedef unsigned short bf16;
#define LAS __attribute__((address_space(3)))

constexpr int NB = 8, SEQ = 4096, D = 1024, FF = 4096, M = NB * SEQ;
constexpr int TCH = 32, NCH = SEQ / TCH;
constexpr int UK = TCH * 16 + 128;
constexpr float EPS = 1e-6f;

constexpr size_t MiB = 1u << 20;
constexpr size_t WS_MOD = 1 * MiB, WS_SHW = 2 * MiB, WS_ABT = 3 * MiB, WS_PART = 4 * MiB, WS_PARTV = 6 * MiB;
constexpr size_t WS_W1 = 8 * MiB, WS_W2 = 40 * MiB, WS_WCI = 72 * MiB, WS_WCO = 84 * MiB, WS_WSI = 88 * MiB, WS_WGLU = 90 * MiB, WS_WSO = 92 * MiB, WS_WGI = 94 * MiB, WS_WGO = 98 * MiB, WS_WST = 100 * MiB;
constexpr size_t WS_TOEP = 101 * MiB, WS_MST = 141 * MiB;
constexpr size_t WS_XA = 160 * MiB, WS_HID = 224 * MiB, WS_T0 = 224 * MiB, WS_T1 = 288 * MiB, WS_T2 = 352 * MiB, WS_T3 = 416 * MiB;
constexpr size_t WS_UEXT = WS_T0, WS_SEND = 304 * MiB, WS_END = 480 * MiB;
constexpr int LDS_BYTES = 147456;

struct Params { const float* in[30]; float* out; unsigned char* ws; };
#ifndef PROBE_ID
#define PROBE_ID 0
#endif
#define PROBE_K 4
#define PB(id) do { if (PROBE_ID == (id)) pr_t0 = __builtin_amdgcn_s_memrealtime(); } while (0)
#define PE(id) do { if (PROBE_ID == (id)) pr_acc += __builtin_amdgcn_s_memrealtime() - pr_t0; } while (0)

__device__ __forceinline__ float wave_sum(float v) {
#pragma unroll
    for (int o = 1; o < 64; o <<= 1) v += __shfl_xor(v, o);
    return v;
}
__device__ __forceinline__ float sum4(f32x4 a) { return (a[0] + a[1]) + (a[2] + a[3]); }
__device__ __forceinline__ float dot4(f32x4 a) { return (a[0] * a[0] + a[1] * a[1]) + (a[2] * a[2] + a[3] * a[3]); }
__device__ __forceinline__ float row_rstd(const float* part, int row) {
    const f32x4* p = (const f32x4*)(part + (size_t)row * 16);
    const f32x4 a = p[0], b = p[1], c = p[2], d = p[3];
    const float s = (sum4(a) + sum4(b)) + (sum4(c) + sum4(d));
    return rsqrtf(s * (1.0f / 1024.0f) + EPS);
}
__device__ __forceinline__ float sigmoid_f(float x) { return __builtin_amdgcn_rcpf(1.0f + __builtin_amdgcn_exp2f(-1.4426950408889634f * x)); }
__device__ __forceinline__ float gelu_tanh_f(float y) { const float t = 0.7978845608028654f * (y + 0.044715f * y * y * y); return y * sigmoid_f(2.0f * t); }


#define XB_TMO      128
#define XB_XCNT(j)  (256  + 64 * (j))
#define XB_XSUB(j)  (1280 + 64 * (j))
#define XB_XGEN(j)  (2304 + 64 * (j))
#define XB_TOP      3328
#define XB_TOPGEN   3392
#define XCD_BAR_WORDS 3456
#define XB_SPIN_CAP (1u << 18)
__device__ __forceinline__ unsigned xb_ld(unsigned* p)              { return __hip_atomic_load(p, __ATOMIC_RELAXED, __HIP_MEMORY_SCOPE_AGENT); }
__device__ __forceinline__ unsigned xb_add(unsigned* p, unsigned v) { return __hip_atomic_fetch_add(p, v, __ATOMIC_RELAXED, __HIP_MEMORY_SCOPE_AGENT); }
__device__ __forceinline__ unsigned xb_xcc_id() { return (unsigned)__builtin_amdgcn_s_getreg((3 << 11) | 20) & 0xFu; }
#define XB_SPIN(cond, bar) do { unsigned _sp = 0; while (cond) { __builtin_amdgcn_s_sleep(1); \
    if ((++_sp & 255u) == 0u) { if (xb_ld(&(bar)[XB_TMO])) break; if (_sp > XB_SPIN_CAP) { atomicAdd(&(bar)[XB_TMO], 1u); break; } } } } while (0)
struct XcdBarrier { unsigned* bar; unsigned x; volatile LAS unsigned* st; };
__device__ __forceinline__ XcdBarrier xcd_barrier_post(unsigned* bar, volatile LAS unsigned* st) {
    XcdBarrier b; b.bar = bar; b.x = xb_xcc_id(); b.st = st;
    if (threadIdx.x == 0) (void)xb_add(&bar[XB_XCNT(b.x)], 1u);
    return b;
}
__device__ __forceinline__ void xcd_barrier_complete(unsigned* bar, unsigned x, unsigned& nloc, unsigned& nx) {
    const unsigned G = gridDim.x * gridDim.y * gridDim.z;
    unsigned sum, cnt, mine, sp = 0u;
    for (;;) {
        sum = 0u; cnt = 0u; mine = 0u;
#pragma unroll
        for (unsigned j = 0; j < 16; ++j) { const unsigned c = xb_ld(&bar[XB_XCNT(j)]); sum += c; cnt += (c > 0u) ? 1u : 0u; mine = (j == x) ? c : mine; }
        if (sum == G) break;
        __builtin_amdgcn_s_sleep(1);
        if ((++sp & 255u) == 0u) { if (xb_ld(&bar[XB_TMO])) break; if (sp > XB_SPIN_CAP) { atomicAdd(&bar[XB_TMO], 1u); break; } }
    }
    nloc = mine > 0u ? mine : 1u; nx = cnt > 0u ? cnt : 1u;
}
__device__ __forceinline__ void xcd_barrier(const XcdBarrier& b) {
    asm volatile("s_waitcnt vmcnt(0)" ::: "memory");
    __syncthreads();
    if (threadIdx.x == 0) {
        unsigned* bar = b.bar;
        __builtin_amdgcn_s_waitcnt(0);
        unsigned nloc = b.st[0], nx = b.st[1];
        if (nloc == 0u) { xcd_barrier_complete(bar, b.x, nloc, nx); b.st[0] = nloc; b.st[1] = nx; }
        const unsigned old = xb_add(&bar[XB_XSUB(b.x)], 1u);
        const unsigned gen = old / nloc;
        if (old + 1u == (gen + 1u) * nloc) {
            __builtin_amdgcn_fence(__ATOMIC_RELEASE, "agent");
            asm volatile("s_waitcnt vmcnt(0)" ::: "memory");
            const unsigned og = xb_add(&bar[XB_TOP], 1u);
            const unsigned tg = og / nx;
            if (og + 1u == (tg + 1u) * nx) xb_add(&bar[XB_TOPGEN], 1u);
            else XB_SPIN(xb_ld(&bar[XB_TOPGEN]) == tg, bar);
            __builtin_amdgcn_fence(__ATOMIC_ACQUIRE, "agent");
            xb_add(&bar[XB_XGEN(b.x)], 1u);
            asm volatile("s_waitcnt vmcnt(0)" ::: "memory");
        } else {
            XB_SPIN(xb_ld(&bar[XB_XGEN(b.x)]) == gen, bar);
            __builtin_amdgcn_fence(__ATOMIC_ACQUIRE, "agent");
            asm volatile("s_waitcnt vmcnt(0)" ::: "memory");
        }
    }
    __syncthreads();
}

template <int MODE  > struct EpiIn {
    const float* part; const float* shw; int N; bf16* O0; bf16* O1; float* partv;
    __device__ __forceinline__ void operator()(const f32x4 (&acc)[2][2][4][2], const pg8::Unit& u, int wr, int wc, int fr, int fq) const {
        const int row0 = u.pm * 256 + wr * 64 + fr, b = u.pm >> 4, colt = u.pn * 256 + wc * 32 + 8 * fq;
        f32x4 bv[2][2];
#pragma unroll
        for (int bj = 0; bj < 2; ++bj)
#pragma unroll
            for (int n = 0; n < 2; ++n) bv[bj][n] = *(const f32x4*)(shw + (size_t)b * N + colt + bj * 128 + 4 * n);
#pragma unroll
        for (int ai = 0; ai < 2; ++ai)
#pragma unroll
            for (int m = 0; m < 4; ++m) {
                const int row = row0 + ai * 128 + m * 16; const float rs = row_rstd(part, row);
                f32x4 v[2][2];
#pragma unroll
                for (int bj = 0; bj < 2; ++bj)
#pragma unroll
                    for (int n = 0; n < 2; ++n) v[bj][n] = acc[ai][bj][m][n] * rs + bv[bj][n];
                if (MODE == 0) {
                    if (u.pn < 4) {
#pragma unroll
                        for (int bj = 0; bj < 2; ++bj) *(u32x4*)(O0 + (size_t)row * D + colt + bj * 128) = pack8(v[bj][0], v[bj][1]);
                    } else {
                        *(u32x4*)(O1 + (size_t)row * D + (u.pn - 4) * 128 + wc * 32 + 8 * fq) = pack8(v[0][0] * v[1][0], v[0][1] * v[1][1]);
                    }
                } else if (MODE == 1) {
                    const int bb = row >> 12, l = row & 4095;
#pragma unroll
                    for (int bj = 0; bj < 2; ++bj) { const int col = colt + bj * 128, gg = col >> 4, h0 = col & 15;
                        *(u32x4*)(O0 + ((size_t)gg * 1024 + bb * NCH + (l >> 5)) * UK + (l & 31) * 16 + h0) = pack8(v[bj][0], v[bj][1]); }
                } else if (MODE == 2) {
                    if (u.pn < 4) {
#pragma unroll
                        for (int bj = 0; bj < 2; ++bj) *(u32x4*)(O0 + (size_t)row * D + colt + bj * 128) = pack8(v[bj][0], v[bj][1]);
                    } else {
                        float ss = (dot4(v[0][0]) + dot4(v[0][1])) + (dot4(v[1][0]) + dot4(v[1][1]));
#pragma unroll
                        for (int bj = 0; bj < 2; ++bj) *(u32x4*)(O1 + (size_t)row * D + (colt - 1024) + bj * 128) = pack8(v[bj][0], v[bj][1]);
                        ss += __shfl_xor(ss, 16); ss += __shfl_xor(ss, 32);
                        if (fq == 0) partv[(size_t)row * 16 + (u.pn - 4) * 4 + wc] = ss;
                    }
                } else {
#pragma unroll
                    for (int bj = 0; bj < 2; ++bj) {
                        f32x4 r0 = __builtin_elementwise_max(v[bj][0], (f32x4){0.f, 0.f, 0.f, 0.f}), r1 = __builtin_elementwise_max(v[bj][1], (f32x4){0.f, 0.f, 0.f, 0.f});
                        *(u32x4*)(O0 + (size_t)row * FF + colt + bj * 128) = pack8(r0 * r0, r1 * r1); }
                }
            }
    }
};
struct EpiRes {
    const float* xin; float* xout; const float* gate; const float* anext; bf16* xa; float* part;
    __device__ __forceinline__ void operator()(const f32x4 (&acc)[2][2][4][2], const pg8::Unit& u, int wr, int wc, int fr, int fq) const {
        const int row0 = u.pm * 256 + wr * 64 + fr, b = u.pm >> 4, colt = u.pn * 256 + wc * 32 + 8 * fq;
        f32x4 gv[2][2], av[2][2];
#pragma unroll
        for (int bj = 0; bj < 2; ++bj)
#pragma unroll
            for (int n = 0; n < 2; ++n) { gv[bj][n] = *(const f32x4*)(gate + b * D + colt + bj * 128 + 4 * n);
                av[bj][n] = anext ? *(const f32x4*)(anext + b * D + colt + bj * 128 + 4 * n) : (f32x4){0.f, 0.f, 0.f, 0.f}; }
#pragma unroll
        for (int ai = 0; ai < 2; ++ai)
#pragma unroll
            for (int m = 0; m < 4; ++m) {
                const int row = row0 + ai * 128 + m * 16; float ss = 0.f;
#pragma unroll
                for (int bj = 0; bj < 2; ++bj) { const size_t off = (size_t)row * D + colt + bj * 128;
                    f32x4 x0 = *(const f32x4*)(xin + off), x1 = *(const f32x4*)(xin + off + 4);
                    x0 = x0 + gv[bj][0] * acc[ai][bj][m][0]; x1 = x1 + gv[bj][1] * acc[ai][bj][m][1];
                    *(f32x4*)(xout + off) = x0; *(f32x4*)(xout + off + 4) = x1;
                    ss += dot4(x0) + dot4(x1);
                    if (anext) *(u32x4*)(xa + off) = pack8(x0 * av[bj][0], x1 * av[bj][1]); }
                ss += __shfl_xor(ss, 16); ss += __shfl_xor(ss, 32);
                if (fq == 0) part[(size_t)row * 16 + u.pn * 4 + wc] = ss;
            }
    }
};
struct EpiS1 {
    float* send;
    __device__ __forceinline__ void operator()(const f32x4 (&acc)[2][2][4][2], const pg8::Unit& u, int wr, int wc, int fr, int fq) const {
        const int row0 = u.pm * 256 + wr * 64 + fr;
#pragma unroll
        for (int ai = 0; ai < 2; ++ai)
#pragma unroll
            for (int m = 0; m < 4; ++m) { float* p = send + ((size_t)u.g * 1024 + row0 + ai * 128 + m * 16) * 128 + wc * 32 + 8 * fq;
                *(f32x4*)p = acc[ai][0][m][0]; *(f32x4*)(p + 4) = acc[ai][0][m][1]; }
    }
};
struct EpiS3 {
    const bf16* uext; const float* dskip; bf16* Y;
    __device__ __forceinline__ void operator()(const f32x4 (&acc)[2][2][4][2], const pg8::Unit& u, int wr, int wc, int fr, int fq) const {
        const int row0 = u.pm * 256 + wr * 64 + fr, colt = u.pn * 256 + wc * 32 + 8 * fq, h0 = colt & 15;
        const f32x4 d0 = *(const f32x4*)(dskip + u.g * 16 + h0), d1 = *(const f32x4*)(dskip + u.g * 16 + h0 + 4);
#pragma unroll
        for (int ai = 0; ai < 2; ++ai)
#pragma unroll
            for (int m = 0; m < 4; ++m) { const int row = row0 + ai * 128 + m * 16;
#pragma unroll
                for (int bj = 0; bj < 2; ++bj) { const int col = colt + bj * 128, t = col >> 4;
                    f32x4 u0, u1; unpack8(*(const u32x4*)(uext + ((size_t)u.g * 1024 + row) * UK + col), u0, u1);
                    f32x4 y0 = acc[ai][bj][m][0] + d0 * u0, y1 = acc[ai][bj][m][1] + d1 * u1;
#pragma unroll
                    for (int e = 0; e < 4; ++e) { y0[e] = gelu_tanh_f(y0[e]); y1[e] = gelu_tanh_f(y1[e]); }
                    *(u32x4*)(Y + ((size_t)row * TCH + t) * D + u.g * 16 + h0) = pack8(y0, y1); } }
    }
};
struct EpiGlu {
    const bf16* Y; const float* gb; bf16* Y2;
    __device__ __forceinline__ void operator()(const f32x4 (&acc)[2][2][4][2], const pg8::Unit& u, int wr, int wc, int fr, int fq) const {
        const int row0 = u.pm * 256 + wr * 64 + fr, colt = u.pn * 256 + wc * 32 + 8 * fq;
        f32x4 bv[2][2];
#pragma unroll
        for (int bj = 0; bj < 2; ++bj)
#pragma unroll
            for (int n = 0; n < 2; ++n) bv[bj][n] = *(const f32x4*)(gb + colt + bj * 128 + 4 * n);
#pragma unroll
        for (int ai = 0; ai < 2; ++ai)
#pragma unroll
            for (int m = 0; m < 4; ++m) { const int row = row0 + ai * 128 + m * 16;
#pragma unroll
                for (int bj = 0; bj < 2; ++bj) { const size_t off = (size_t)row * D + colt + bj * 128;
                    f32x4 y0, y1; unpack8(*(const u32x4*)(Y + off), y0, y1);
                    f32x4 z0 = acc[ai][bj][m][0] + bv[bj][0], z1 = acc[ai][bj][m][1] + bv[bj][1];
#pragma unroll
                    for (int e = 0; e < 4; ++e) { y0[e] *= sigmoid_f(z0[e]); y1[e] *= sigmoid_f(z1[e]); }
                    *(u32x4*)(Y2 + off) = pack8(y0, y1); } }
    }
};

__device__ __forceinline__ void transpose_item(const float* W, int K, int N, bf16* WT, int mode, LAS float* scr, int item, int lane) {
    const int nblk = N / 64, kb = item / nblk, nb = item % nblk, k0 = 64 * kb, n0 = 64 * nb;
    int drow = n0;
    if (mode == 1 && n0 >= 1024) { int nn = n0 - 1024; const int half = nn >> 10; nn &= 1023; drow = 1024 + 256 * (nn >> 7) + 128 * half + (nn & 127); }
    const int kr = lane >> 4, nc = (lane & 15) * 4;
    f32x4 v[16];
#pragma unroll
    for (int i = 0; i < 16; ++i) v[i] = *(const f32x4*)(W + (size_t)(k0 + 4 * i + kr) * N + n0 + nc);
#pragma unroll
    for (int i = 0; i < 16; ++i) { LAS float* d = scr + (4 * i + kr) * 65 + nc; d[0] = v[i][0]; d[1] = v[i][1]; d[2] = v[i][2]; d[3] = v[i][3]; }
    asm volatile("s_waitcnt lgkmcnt(0)" ::: "memory");
    const int c = lane & 7;
#pragma unroll
    for (int j = 0; j < 8; ++j) { const int n = (lane >> 3) + 8 * j; const LAS float* sp = scr + (8 * c) * 65 + n;
        u32x4 o; o.x = cvt_pk_bf16(sp[0 * 65], sp[1 * 65]); o.y = cvt_pk_bf16(sp[2 * 65], sp[3 * 65]); o.z = cvt_pk_bf16(sp[4 * 65], sp[5 * 65]); o.w = cvt_pk_bf16(sp[6 * 65], sp[7 * 65]);
        *(u32x4*)(WT + (size_t)(drow + n) * K + k0 + 8 * c) = o; }
    asm volatile("s_waitcnt lgkmcnt(0)" ::: "memory");
}

__global__ void __launch_bounds__(512, 2) mk_fwd(Params P) {
    extern __shared__ __attribute__((aligned(16))) unsigned char lds_raw[];
    cg::grid_group grid = cg::this_grid();
    LAS unsigned char* lds = (LAS unsigned char*)lds_raw;
    const int G = gridDim.x;
    const int NGW = G * 8;
#define FRESH_TID() int bid = blockIdx.x; asm volatile("" : "+s"(bid)); const int vcu = (G % 8 == 0) ? (bid % 8) * (G / 8) + bid / 8 : bid; (void)vcu; int tid = threadIdx.x; asm volatile("" : "+v"(tid)); const int lane = tid & 63, wave = __builtin_amdgcn_readfirstlane(tid >> 6); const int gw = bid * 8 + wave; (void)lane; (void)gw
    unsigned char* ws = P.ws;
    float* modv = (float*)(ws + WS_MOD); float* shw = (float*)(ws + WS_SHW); float* abt = (float*)(ws + WS_ABT);
    float* part = (float*)(ws + WS_PART); float* partv = (float*)(ws + WS_PARTV);
    bf16* W1t = (bf16*)(ws + WS_W1); bf16* W2t = (bf16*)(ws + WS_W2); bf16* Wci = (bf16*)(ws + WS_WCI); bf16* Wco = (bf16*)(ws + WS_WCO);
    bf16* Wsi = (bf16*)(ws + WS_WSI); bf16* Wglu = (bf16*)(ws + WS_WGLU); bf16* Wso = (bf16*)(ws + WS_WSO); bf16* Wgi = (bf16*)(ws + WS_WGI); bf16* Wgo = (bf16*)(ws + WS_WGO);
    bf16* WSt = (bf16*)(ws + WS_WST); bf16* Toep = (bf16*)(ws + WS_TOEP); bf16* Mst = (bf16*)(ws + WS_MST);
    bf16* XA = (bf16*)(ws + WS_XA); bf16* HID = (bf16*)(ws + WS_HID); bf16* T0 = (bf16*)(ws + WS_T0); bf16* T1 = (bf16*)(ws + WS_T1); bf16* T2 = (bf16*)(ws + WS_T2); bf16* T3 = (bf16*)(ws + WS_T3);
    bf16* UEXT = (bf16*)(ws + WS_UEXT); float* SEND = (float*)(ws + WS_SEND);
    float* X = P.out;
    unsigned long long pr_acc = 0, pr_t0 = 0; (void)pr_acc; (void)pr_t0;
    volatile LAS unsigned* misc = (volatile LAS unsigned*)(lds + LDS_BYTES - 64);
    if (threadIdx.x < 2) misc[threadIdx.x] = 0u;
    __syncthreads();
    const XcdBarrier xbar = xcd_barrier_post((unsigned*)ws, misc);
#define GRID_BAR() xcd_barrier(xbar)
    PB(1);

    {
    FRESH_TID();
    for (int it = bid; it < 96; it += G) {
        LAS float* cs = (LAS float*)lds; LAS float* red = cs + 8192;
        const float* c = P.in[1];
        for (int e = tid; e < 8192; e += 512) { const float v = c[e]; cs[e] = v / (1.0f + __expf(-v)); }
        __syncthreads();
        const int i = it / 24, n0 = (it % 24) * 256;
        const float* W = P.in[2] + (size_t)i * 1024 * 6144 + n0 + 4 * lane;
        f32x4 acc[8];
#pragma unroll
        for (int b = 0; b < 8; ++b) acc[b] = (f32x4){0.f, 0.f, 0.f, 0.f};
        const int k0 = wave * 128;
        for (int kk = 0; kk < 128; kk += 16) { f32x4 w[16];
#pragma unroll
            for (int k = 0; k < 16; ++k) w[k] = *(const f32x4*)(W + (size_t)(k0 + kk + k) * 6144);
#pragma unroll
            for (int k = 0; k < 16; ++k)
#pragma unroll
                for (int b = 0; b < 8; ++b) acc[b] += cs[b * 1024 + k0 + kk + k] * w[k]; }
#pragma unroll
        for (int b = 0; b < 8; ++b) *(LAS f32x4*)(red + (wave * 8 + b) * 256 + 4 * lane) = acc[b];
        __syncthreads();
#pragma unroll
        for (int j = 0; j < 4; ++j) { const int o = tid + 512 * j, b = o >> 8, nn = o & 255, n = n0 + nn, kind = n >> 10, col = n & 1023;
            float s = P.in[3][i * 6144 + n];
#pragma unroll
            for (int w = 0; w < 8; ++w) s += red[(w * 8 + b) * 256 + nn];
            if (kind == 1) s = (1.0f + s) * P.in[4][i * 1024 + col];
            if (kind == 4) s = (1.0f + s) * P.in[5][i * 1024 + col];
            const int slot = kind == 0 ? 1 : kind == 1 ? 0 : kind == 2 ? 2 : kind == 3 ? 4 : kind == 4 ? 3 : 5;
            modv[((i * 6 + slot) * 8 + b) * 1024 + col] = s; }
        __syncthreads();
    }
    for (int it = bid; it < 256; it += G) {
        const int g = it >> 2, q = it & 3;
        LAS float* pw_re = (LAS float*)lds; LAS float* pw_im = pw_re + 33 * 65; LAS float* bb_re = pw_im + 33 * 65; LAS float* bb_im = bb_re + 1024;
        LAS float* cc_re = bb_im + 1024; LAS float* cc_im = cc_re + 16 * 65; LAS float* Kd = cc_im + 16 * 65;
        __syncthreads();
        if (tid < 64) { const int p = tid;
            const float dt = expf(P.in[16][g]); const float are = P.in[14][g * 64 + p], aim = P.in[15][g * 64 + p];
            const float mag = expf(are * dt); float sn, cs_; sincosf(aim * dt, &sn, &cs_);
            const float abr = mag * cs_, abi = mag * sn, den = are * are + aim * aim, nr = abr - 1.0f, ni = abi;
            const float fre = (nr * are + ni * aim) / den, fim = (ni * are - nr * aim) / den;
            float pr = 1.0f, pi = 0.0f;
            for (int d = 0; d <= 32; ++d) { pw_re[d * 65 + p] = pr; pw_im[d * 65 + p] = pi; const float npr = pr * abr - pi * abi, npi = pr * abi + pi * abr; pr = npr; pi = npi; }
            for (int h = 0; h < 16; ++h) { const float br = P.in[17][(g * 64 + p) * 16 + h], bi = P.in[18][(g * 64 + p) * 16 + h]; bb_re[p * 16 + h] = fre * br - fim * bi; bb_im[p * 16 + h] = fre * bi + fim * br; }
            if (q == 0) { abt[(g * 64 + p) * 2] = pw_re[32 * 65 + p]; abt[(g * 64 + p) * 2 + 1] = pw_im[32 * 65 + p]; }
        }
        for (int e = tid; e < 1024; e += 512) { const int h = e >> 6, p = e & 63; cc_re[h * 65 + p] = P.in[19][g * 1024 + e]; cc_im[h * 65 + p] = P.in[20][g * 1024 + e]; }
        __syncthreads();
        { const int d = tid >> 4, h = tid & 15; float s[16];
#pragma unroll
            for (int e = 0; e < 16; ++e) s[e] = 0.f;
            for (int p = 0; p < 64; ++p) { const float cr = cc_re[h * 65 + p], ci = cc_im[h * 65 + p], pr = pw_re[d * 65 + p], pi = pw_im[d * 65 + p];
                const float wre = cr * pr - ci * pi, wim = cr * pi + ci * pr;
#pragma unroll
                for (int e = 0; e < 16; ++e) s[e] += wre * bb_re[p * 16 + e] - wim * bb_im[p * 16 + e]; }
#pragma unroll
            for (int e = 0; e < 16; ++e) Kd[(d * 16 + h) * 16 + e] = s[e]; }
        __syncthreads();
        for (int v = tid; v < 10240; v += 512) { const int rr = v / 80, kv = v % 80, n = 128 * q + rr, t = n >> 4, h = n & 15, k0 = 8 * kv;
            float val[8];
            if (k0 < 512) { const int j = k0 >> 4, h0 = k0 & 15;
#pragma unroll
                for (int e = 0; e < 8; ++e) val[e] = (j <= t) ? Kd[((t - j) * 16 + h) * 16 + h0 + e] : 0.f;
            } else { const int p0 = (k0 - 512) >> 1;
#pragma unroll
                for (int pp = 0; pp < 4; ++pp) { const int p = p0 + pp; const float cr = cc_re[h * 65 + p], ci = cc_im[h * 65 + p], pr = pw_re[(t + 1) * 65 + p], pi = pw_im[(t + 1) * 65 + p];
                    val[2 * pp] = cr * pr - ci * pi; val[2 * pp + 1] = -(cr * pi + ci * pr); } }
            u32x4 o; o.x = cvt_pk_bf16(val[0], val[1]); o.y = cvt_pk_bf16(val[2], val[3]); o.z = cvt_pk_bf16(val[4], val[5]); o.w = cvt_pk_bf16(val[6], val[7]);
            *(u32x4*)(Toep + ((size_t)g * 512 + n) * UK + k0) = o; }
        for (int v = tid; v < 4096; v += 512) { const int rr = v >> 6, kv = v & 63, n = 64 * q + rr, k0 = 8 * kv, j = k0 >> 4, h0 = k0 & 15;
            float val[8];
            if (n < 128) { const int p = n >> 1, ri = n & 1, d = 31 - j; const float pr = pw_re[d * 65 + p], pi = pw_im[d * 65 + p];
#pragma unroll
                for (int e = 0; e < 8; ++e) { const float br = bb_re[p * 16 + h0 + e], bi = bb_im[p * 16 + h0 + e]; val[e] = ri == 0 ? (pr * br - pi * bi) : (pr * bi + pi * br); }
            } else {
#pragma unroll
                for (int e = 0; e < 8; ++e) val[e] = 0.f; }
            u32x4 o; o.x = cvt_pk_bf16(val[0], val[1]); o.y = cvt_pk_bf16(val[2], val[3]); o.z = cvt_pk_bf16(val[4], val[5]); o.w = cvt_pk_bf16(val[6], val[7]);
            *(u32x4*)(Mst + ((size_t)g * 256 + n) * 512 + k0) = o; }
        __syncthreads();
    }
    for (int e = bid * 512 + tid; e < 8 * 128 * 128; e += G * 512) { const int t = (e >> 7) & 127, s = e & 127; WSt[e] = (s <= t) ? (bf16)(cvt_pk_bf16(P.in[27][e], 0.f) & 0xffffu) : (bf16)0; }
    {
        LAS float* scr = (LAS float*)(lds + wave * 16640);
        __syncthreads();
        for (int it = gw; it < 11776; it += NGW) {
            int r = it;
            if (r < 4096) { const int mt = r >> 10; transpose_item(P.in[6] + (size_t)mt * D * FF, D, FF, W1t + (size_t)mt * D * FF, 0, scr, r & 1023, lane); continue; } r -= 4096;
            if (r < 4096) { const int mt = r >> 10; transpose_item(P.in[7] + (size_t)mt * D * FF, FF, D, W2t + (size_t)mt * D * FF, 0, scr, r & 1023, lane); continue; } r -= 4096;
            if (r < 1536) { const int mt = r / 768; transpose_item(P.in[9] + (size_t)mt * D * 3072, D, 3072, Wci + (size_t)mt * D * 3072, 1, scr, r % 768, lane); continue; } r -= 1536;
            if (r < 512) { const int mt = r >> 8; transpose_item(P.in[12] + (size_t)mt * D * D, D, D, Wco + (size_t)mt * D * D, 0, scr, r & 255, lane); continue; } r -= 512;
            if (r < 256) { transpose_item(P.in[13], D, D, Wsi, 0, scr, r, lane); continue; } r -= 256;
            if (r < 256) { transpose_item(P.in[22], D, D, Wglu, 0, scr, r, lane); continue; } r -= 256;
            if (r < 256) { transpose_item(P.in[24], D, D, Wso, 0, scr, r, lane); continue; } r -= 256;
            if (r < 512) { transpose_item(P.in[25], D, 2048, Wgi, 0, scr, r, lane); continue; } r -= 512;
            transpose_item(P.in[29], D, D, Wgo, 0, scr, r, lane);
        }
    }
    }
    grid.sync();
    PE(1); PB(2);

    {
    FRESH_TID();
    for (int r = gw; r < 25600; r += NGW) {
        int start, N, layer, slot; const bf16* Wt;
        if (r < 3072) { start = 0; N = 3072; Wt = Wci; layer = 0; slot = 1; }
        else if (r < 7168) { start = 3072; N = 4096; Wt = W1t; layer = 0; slot = 4; }
        else if (r < 8192) { start = 7168; N = 1024; Wt = Wsi; layer = 1; slot = 1; }
        else if (r < 12288) { start = 8192; N = 4096; Wt = W1t + (size_t)1 * D * FF; layer = 1; slot = 4; }
        else if (r < 14336) { start = 12288; N = 2048; Wt = Wgi; layer = 2; slot = 1; }
        else if (r < 18432) { start = 14336; N = 4096; Wt = W1t + (size_t)2 * D * FF; layer = 2; slot = 4; }
        else if (r < 21504) { start = 18432; N = 3072; Wt = Wci + (size_t)D * 3072; layer = 3; slot = 1; }
        else { start = 21504; N = 4096; Wt = W1t + (size_t)3 * D * FF; layer = 3; slot = 4; }
        const int n = r - start;
        f32x4 w0, w1, w2, w3; unpack8(*(const u32x4*)(Wt + (size_t)n * D + 8 * lane), w0, w1); unpack8(*(const u32x4*)(Wt + (size_t)n * D + 512 + 8 * lane), w2, w3);
        const float* sh = modv + (size_t)((layer * 6 + slot) * 8) * 1024;
        float sv[8];
#pragma unroll
        for (int b = 0; b < 8; ++b) { const f32x4* p0 = (const f32x4*)(sh + b * 1024 + 8 * lane); const f32x4* p1 = (const f32x4*)(sh + b * 1024 + 512 + 8 * lane);
            const f32x4 t = p0[0] * w0 + p0[1] * w1 + p1[0] * w2 + p1[1] * w3; sv[b] = sum4(t); }
#pragma unroll
        for (int o = 1; o < 64; o <<= 1) {
#pragma unroll
            for (int b = 0; b < 8; ++b) sv[b] += __shfl_xor(sv[b], o); }
        if (lane < 8) { float s = sv[0];
#pragma unroll
            for (int b = 1; b < 8; ++b) s = (lane == b) ? sv[b] : s;
            shw[(size_t)8 * start + (size_t)lane * N + n] = s; }
    }
    for (int m0 = gw * 4; m0 < M; m0 += NGW * 4) {
        const f32x4* ar = (const f32x4*)(modv + (size_t)(m0 >> 12) * 1024) + lane;
        f32x4 v[4][4]; float s[4];
#pragma unroll
        for (int r = 0; r < 4; ++r)
#pragma unroll
            for (int j = 0; j < 4; ++j) v[r][j] = *((const f32x4*)(P.in[0] + (size_t)(m0 + r) * D) + lane + 64 * j);
#pragma unroll
        for (int r = 0; r < 4; ++r) { s[r] = 0.f;
#pragma unroll
            for (int j = 0; j < 4; ++j) s[r] += dot4(v[r][j]); }
#pragma unroll
        for (int o = 1; o < 64; o <<= 1) {
#pragma unroll
            for (int r = 0; r < 4; ++r) s[r] += __shfl_xor(s[r], o); }
#pragma unroll
        for (int r = 0; r < 4; ++r) {
#pragma unroll
            for (int j = 0; j < 4; ++j) { const f32x4 o = v[r][j] * ar[64 * j]; u32x2 w; w.x = cvt_pk_bf16(o[0], o[1]); w.y = cvt_pk_bf16(o[2], o[3]); *((u32x2*)(XA + (size_t)(m0 + r) * D) + lane + 64 * j) = w; }
            if (lane < 16) part[(size_t)(m0 + r) * 16 + lane] = (lane == 0) ? s[r] : 0.f; }
    }
    }
    GRID_BAR();
    PE(2);

#pragma unroll 1
    for (int li = 0; li < 4; ++li) {
        FRESH_TID();
        const int kind = li % 3, jm = li / 3;
        const float* mv = modv + (size_t)li * 6 * 8192;
        const int mstart = li == 0 ? 0 : li == 1 ? 7168 : li == 2 ? 12288 : 18432;
        const int fstart = li == 0 ? 3072 : li == 1 ? 8192 : li == 2 ? 14336 : 21504;
        const bf16* wout_t; const bf16* aout;
        if (kind == 0) {
            PB(6);
            {   pg8::Gemm g{XA, Wci + (size_t)jm * D * 3072, D, D, D, 0, 0}; pg8::StaticOrder S; S.init(M, 3072, G, bid);
                EpiIn<0> E{part, shw + (size_t)8 * mstart, 3072, T0, T1, nullptr};
                pg8::gemm_phase<EpiIn<0>, pg8::StaticOrder, true>(lds, g, S, E); }
            GRID_BAR();
            PE(6); PB(8);
            {
                const float* cw = P.in[10] + (size_t)jm * 3 * D; const float* cb = P.in[11] + (size_t)jm * D;
                for (int run = bid * 4 + (tid >> 7); run < M / 32; run += G * 4) {
                    const int tok0 = run * 32, col = (tid & 127) * 8;
                    f32x4 c0a = *(const f32x4*)(cw + col), c0b = *(const f32x4*)(cw + col + 4), c1a = *(const f32x4*)(cw + D + col), c1b = *(const f32x4*)(cw + D + col + 4);
                    f32x4 c2a = *(const f32x4*)(cw + 2 * D + col), c2b = *(const f32x4*)(cw + 2 * D + col + 4), cba = *(const f32x4*)(cb + col), cbb = *(const f32x4*)(cb + col + 4);
                    f32x4 z1a = {0.f, 0.f, 0.f, 0.f}, z1b = z1a, z2a = z1a, z2b = z1a;
                    if ((tok0 & (SEQ - 1)) != 0) { unpack8(*(const u32x4*)(T1 + (size_t)(tok0 - 1) * D + col), z1a, z1b); unpack8(*(const u32x4*)(T1 + (size_t)(tok0 - 2) * D + col), z2a, z2b); }
                    for (int t0 = 0; t0 < 32; t0 += 8) { u32x4 zr[8], br[8];
#pragma unroll
                        for (int t = 0; t < 8; ++t) { const size_t off = (size_t)(tok0 + t0 + t) * D + col; zr[t] = *(const u32x4*)(T1 + off); br[t] = *(const u32x4*)(T0 + off); }
#pragma unroll
                        for (int t = 0; t < 8; ++t) { const size_t off = (size_t)(tok0 + t0 + t) * D + col;
                            f32x4 za, zb, ba, bb; unpack8(zr[t], za, zb); unpack8(br[t], ba, bb);
                            const f32x4 oa = ba * (c0a * z2a + c1a * z1a + c2a * za + cba), ob = bb * (c0b * z2b + c1b * z1b + c2b * zb + cbb);
                            *(u32x4*)(T2 + off) = pack8(oa, ob);
                            z2a = z1a; z2b = z1b; z1a = za; z1b = zb; } }
                }
            }
            GRID_BAR();
            PE(8);
            wout_t = Wco + (size_t)jm * D * D; aout = T2;
        } else if (kind == 1) {
            PB(6);
            {   pg8::Gemm g{XA, Wsi, D, D, D, 0, 0}; pg8::StaticOrder S; S.init(M, D, G, bid);
                EpiIn<1> E{part, shw + (size_t)8 * mstart, D, UEXT, nullptr, nullptr};
                pg8::gemm_phase<EpiIn<1>, pg8::StaticOrder, true>(lds, g, S, E); }
            GRID_BAR();
            PE(6); PB(7);
            {   pg8::Gemm g{UEXT, Mst, 512, UK, 512, (size_t)1024 * UK * 2, (size_t)256 * 512 * 2}; pg8::GroupOrder S; S.init(4, 1, 64, G, vcu);
                EpiS1 E{SEND};
                pg8::gemm_phase<EpiS1, pg8::GroupOrder, true>(lds, g, S, E); }
            GRID_BAR();
            for (int wg = wave * G + bid; wg < 512; wg += 8 * G) { const int b = wg & 7, g = wg >> 3, p = lane;
                const float ar = abt[(g * 64 + p) * 2], ai = abt[(g * 64 + p) * 2 + 1];
                const float* se = SEND + ((size_t)g * 1024 + b * NCH) * 128 + 2 * p;
                bf16* so = UEXT + ((size_t)g * 1024 + b * NCH) * UK + 512 + 2 * p;
                float sr = 0.f, si = 0.f;
                *(unsigned*)so = 0u;
                for (int c0 = 0; c0 < NCH; c0 += 16) { float er[16], ei[16];
#pragma unroll
                    for (int j = 0; j < 16; ++j) { const float2 e = *(const float2*)(se + (size_t)(c0 + j) * 128); er[j] = e.x; ei[j] = e.y; }
#pragma unroll
                    for (int j = 0; j < 16; ++j) { const float nr = ar * sr - ai * si + er[j], ni = ar * si + ai * sr + ei[j]; sr = nr; si = ni;
                        if (c0 + j + 1 < NCH) *(unsigned*)(so + (size_t)(c0 + j + 1) * UK) = cvt_pk_bf16(sr, si); } }
            }
            GRID_BAR();
            {   pg8::Gemm g{UEXT, Toep, UK, UK, UK, (size_t)1024 * UK * 2, (size_t)512 * UK * 2}; pg8::GroupOrder S; S.init(4, 2, 64, G, vcu);
                EpiS3 E{UEXT, P.in[21], T2};
                pg8::gemm_phase<EpiS3, pg8::GroupOrder, true>(lds, g, S, E); }
            GRID_BAR();
            {   pg8::Gemm g{T2, Wglu, D, D, D, 0, 0}; pg8::StaticOrder S; S.init(M, D, G, bid);
                EpiGlu E{T2, P.in[23], T3};
                pg8::gemm_phase<EpiGlu, pg8::StaticOrder, true>(lds, g, S, E); }
            GRID_BAR();
            PE(7);
            wout_t = Wso; aout = T3;
        } else {
            PB(6);
            {   pg8::Gemm g{XA, Wgi, D, D, D, 0, 0}; pg8::StaticOrder S; S.init(M, 2048, G, bid);
                EpiIn<2> E{part, shw + (size_t)8 * mstart, 2048, T0, T1, partv};
                pg8::gemm_phase<EpiIn<2>, pg8::StaticOrder, true>(lds, g, S, E); }
            GRID_BAR();
            PE(6); PB(8);
            for (int cn = bid; cn < M / 128; cn += G) {
                LAS float* rstd_s = (LAS float*)lds; LAS bf16* wsA = (LAS bf16*)(lds + 1024); LAS bf16* vT = wsA + 128 * 136;
                const int wr = wave >> 1, wc = wave & 1, fr = lane & 15, fq = lane >> 4;
                __syncthreads();
                if (tid < 128) rstd_s[tid] = row_rstd(partv, cn * 128 + tid);
                u32x4 wreg[4], vreg[4]; u32x2 ucur[2][4], unxt[2][4];
#define SG_LOAD(hd_) do { _Pragma("unroll") for (int j = 0; j < 4; ++j) { const int ch = tid + 512 * j, r = ch >> 4, c8 = (ch & 15) * 8; \
                        wreg[j] = *(const u32x4*)(WSt + (hd_) * 16384 + r * 128 + c8); vreg[j] = *(const u32x4*)(T1 + (size_t)(cn * 128 + r) * D + (hd_) * 128 + c8); } \
                    _Pragma("unroll") for (int mi = 0; mi < 2; ++mi) _Pragma("unroll") for (int ni = 0; ni < 4; ++ni) \
                        unxt[mi][ni] = *(const u32x2*)(T0 + (size_t)(cn * 128 + 32 * wr + 16 * mi + fr) * D + (hd_) * 128 + 64 * wc + 16 * ni + 4 * fq); } while (0)
                SG_LOAD(0);
                __syncthreads();
                for (int hd = 0; hd < 8; ++hd) {
#pragma unroll
                    for (int j = 0; j < 4; ++j) { const int ch = tid + 512 * j, r = ch >> 4, c8 = (ch & 15) * 8;
                        *(LAS u32x4*)(wsA + r * 136 + c8) = wreg[j];
                        f32x4 va, vb; unpack8(vreg[j], va, vb);
                        const float rs = rstd_s[r]; const f32x4 ga = *(const f32x4*)(P.in[26] + hd * 128 + c8), gb = *(const f32x4*)(P.in[26] + hd * 128 + c8 + 4);
                        va = va * rs * ga; vb = vb * rs * gb;
                        const int pc = r ^ c8;
#pragma unroll
                        for (int e = 0; e < 4; ++e) { vT[(c8 + e) * 136 + pc] = (bf16)(cvt_pk_bf16(va[e], 0.f) & 0xffffu); vT[(c8 + 4 + e) * 136 + pc] = (bf16)(cvt_pk_bf16(vb[e], 0.f) & 0xffffu); } }
#pragma unroll
                    for (int mi = 0; mi < 2; ++mi)
#pragma unroll
                        for (int ni = 0; ni < 4; ++ni) ucur[mi][ni] = unxt[mi][ni];
                    __syncthreads();
                    if (hd + 1 < 8) SG_LOAD(hd + 1);
                    f32x4 acc[2][4];
#pragma unroll
                    for (int mi = 0; mi < 2; ++mi)
#pragma unroll
                        for (int ni = 0; ni < 4; ++ni) acc[mi][ni] = (f32x4){0.f, 0.f, 0.f, 0.f};
                    for (int ks = 0; ks <= wr; ++ks) { bf16x8 a[2], bfr[4];
#pragma unroll
                        for (int mi = 0; mi < 2; ++mi) a[mi] = *(const LAS bf16x8*)(wsA + (32 * wr + 16 * mi + fr) * 136 + 32 * ks + 8 * fq);
#pragma unroll
                        for (int ni = 0; ni < 4; ++ni) { const int dh = 64 * wc + 16 * ni + fr; bfr[ni] = *(const LAS bf16x8*)(vT + dh * 136 + ((32 * ks + 8 * fq) ^ (dh & 0x78))); }
#pragma unroll
                        for (int mi = 0; mi < 2; ++mi)
#pragma unroll
                            for (int ni = 0; ni < 4; ++ni) acc[mi][ni] = __builtin_amdgcn_mfma_f32_16x16x32_bf16(bfr[ni], a[mi], acc[mi][ni], 0, 0, 0); }
#pragma unroll
                    for (int mi = 0; mi < 2; ++mi) { const int t = 32 * wr + 16 * mi + fr; const float bs = P.in[28][hd * 128 + t];
#pragma unroll
                        for (int ni = 0; ni < 4; ++ni) { const size_t off = (size_t)(cn * 128 + t) * D + hd * 128 + 64 * wc + 16 * ni + 4 * fq;
                            const u32x2 uw = ucur[mi][ni];
                            f32x4 uu; uu[0] = __uint_as_float(uw.x << 16); uu[1] = __uint_as_float(uw.x & 0xffff0000u); uu[2] = __uint_as_float(uw.y << 16); uu[3] = __uint_as_float(uw.y & 0xffff0000u);
                            const f32x4 o = uu * (acc[mi][ni] + bs); u32x2 w; w.x = cvt_pk_bf16(o[0], o[1]); w.y = cvt_pk_bf16(o[2], o[3]);
                            *(u32x2*)(T2 + off) = w; } }
                    __syncthreads();
                }
#undef SG_LOAD
            }
            GRID_BAR();
            PE(8);
            wout_t = Wgo; aout = T2;
        }
#pragma unroll 1
        for (int half = 0; half < 2; ++half) {
            if (half == 1) {
                PB(3);
                pg8::Gemm g{XA, W1t + (size_t)li * D * FF, D, D, D, 0, 0}; pg8::StaticOrder S; S.init(M, FF, G, bid);
                EpiIn<3> E{part, shw + (size_t)8 * fstart, FF, HID, nullptr, nullptr};
                pg8::gemm_phase<EpiIn<3>, pg8::StaticOrder, true>(lds, g, S, E);
                GRID_BAR();
                PE(3);
            }
            if (half == 0) PB(5); else PB(4);
            pg8::Gemm g; g.gsA = 0; g.gsB = 0;
            if (half == 0) { g.A = aout; g.Bt = wout_t; g.K = D; g.lda = D; g.ldb = D; }
            else { g.A = HID; g.Bt = W2t + (size_t)li * D * FF; g.K = FF; g.lda = FF; g.ldb = FF; }
            pg8::StaticOrder S; S.init(M, D, G, bid);
            EpiRes E; E.xin = (li == 0 && half == 0) ? P.in[0] : X; E.xout = X; E.gate = mv + (half == 0 ? 2 : 5) * 8192;
            E.anext = half == 0 ? mv + 3 * 8192 : (li < 3 ? modv + (size_t)(li + 1) * 6 * 8192 : nullptr); E.xa = XA; E.part = part;
            pg8::gemm_phase<EpiRes, pg8::StaticOrder, true>(lds, g, S, E);
            GRID_BAR();
            if (half == 0) PE(5); else PE(4);
        }
        if (PROBE_ID == 9) { PB(9); GRID_BAR(); PE(9); }
    }
    if (PROBE_ID) { if (blockIdx.x == 0) { const unsigned long long t0 = __builtin_amdgcn_s_memrealtime(); while (__builtin_amdgcn_s_memrealtime() - t0 < PROBE_K * pr_acc) __builtin_amdgcn_s_sleep(8); } GRID_BAR(); }
    PB(2);
    FRESH_TID();
    for (int m0 = gw * 4; m0 < M; m0 += NGW * 4) {
        const f32x4* gr = (const f32x4*)P.in[8] + lane;
        f32x4 v[4][4]; float s[4];
#pragma unroll
        for (int r = 0; r < 4; ++r)
#pragma unroll
            for (int j = 0; j < 4; ++j) v[r][j] = *((const f32x4*)(X + (size_t)(m0 + r) * D) + lane + 64 * j);
#pragma unroll
        for (int r = 0; r < 4; ++r) { s[r] = 0.f;
#pragma unroll
            for (int j = 0; j < 4; ++j) s[r] += dot4(v[r][j]); }
#pragma unroll
        for (int o = 1; o < 64; o <<= 1) {
#pragma unroll
            for (int r = 0; r < 4; ++r) s[r] += __shfl_xor(s[r], o); }
#pragma unroll
        for (int r = 0; r < 4; ++r) { const float rs = rsqrtf(s[r] * (1.0f / 1024.0f) + EPS);
#pragma unroll
            for (int j = 0; j < 4; ++j) *((f32x4*)(X + (size_t)(m0 + r) * D) + lane + 64 * j) = v[r][j] * rs * gr[64 * j]; }
    }
    if (PROBE_ID == 2) { GRID_BAR(); PE(2); if (blockIdx.x == 0) { const unsigned long long t0 = __builtin_amdgcn_s_memrealtime(); while (__builtin_amdgcn_s_memrealtime() - t0 < PROBE_K * pr_acc) __builtin_amdgcn_s_sleep(8); } GRID_BAR(); }
}

extern "C" void kernel_launch(void* const* d_in, const int* in_sizes, int n_in, void* d_out, int out_size, void* d_ws, size_t ws_size, hipStream_t stream) {
    static int grid = 0;
    if (grid == 0) {
        if (n_in != 30 || out_size != M * D || ws_size < WS_END) { fprintf(stderr, "kernel_launch: unexpected problem (n_in %d, out %d, ws %zu)\n", n_in, out_size, ws_size); grid = -1; return; }
        int dev = 0, cus = 0, per_cu = 0;
        hipGetDevice(&dev); hipDeviceGetAttribute(&cus, hipDeviceAttributeMultiprocessorCount, dev);
        if (hipFuncSetAttribute((const void*)mk_fwd, hipFuncAttributeMaxDynamicSharedMemorySize, LDS_BYTES) != hipSuccess) fprintf(stderr, "kernel_launch: hipFuncSetAttribute failed\n");
        if (hipOccupancyMaxActiveBlocksPerMultiprocessor(&per_cu, (const void*)mk_fwd, 512, LDS_BYTES) != hipSuccess || per_cu < 1) per_cu = 1;
        (void)hipGetLastError();
        grid = cus * per_cu; if (grid > 256) grid = 256; if (grid < 1) grid = 256;
    }
    if (grid < 0) return;
    Params p{};
    for (int i = 0; i < 30; ++i) p.in[i] = (const float*)d_in[i];
    p.out = (float*)d_out; p.ws = (unsigned char*)d_ws;
    void* args[] = {&p};
    if (hipMemsetAsync(d_ws, 0, 16384, stream) != hipSuccess) fprintf(stderr, "kernel_launch: memset of the barrier words failed\n");
    hipError_t e = hipLaunchCooperativeKernel((const void*)mk_fwd, dim3(grid), dim3(512), args, LDS_BYTES, stream);
    if (e != hipSuccess) fprintf(stderr, "cooperative launch failed: %s (grid %d)\n", hipGetErrorString(e), grid);
}
```

```cpp
#include <hip/hip_runtime.h>
#include <hip/hip_cooperative_groups.h>
#include <cstdio>
#include <cstdint>
namespace cg = cooperative_groups;

namespace pg8 {
#define PG8_LAS __attribute__((address_space(3)))
typedef unsigned short bf16_t;
typedef short bf16x8 __attribute__((ext_vector_type(8)));
typedef float f32x4 __attribute__((ext_vector_type(4)));
typedef unsigned u32x4 __attribute__((ext_vector_type(4)));
typedef unsigned u32x2 __attribute__((ext_vector_type(2)));
constexpr int BM = 256, BK = 64, HALF = 128, HTB = HALF * BK * 2, STAGE_BYTES = 8 * HTB, NXCD = 8, WGM = 8;

__host__ __device__ __forceinline__ int lds_byte(int r, int c) { const int st = (r >> 4) * 2 + (c >> 5), rr = r & 15, cc = c & 31, ob = rr * 64 + cc * 2; return st * 1024 + (ob ^ (((ob >> 9) & 1) << 5)); }
__host__ __device__ __forceinline__ void stage_rc(int b, int& R, int& C) { const int st = b / 1024, sb = b % 1024, swz = sb ^ (((sb >> 9) & 1) << 5); R = (st >> 1) * 16 + swz / 64; C = (st & 1) * 32 + (swz % 64) / 2; }
__host__ __device__ __forceinline__ int perm32(int rho) { const int n = rho >> 4, i = rho & 15; return 8 * (i >> 2) + 4 * n + (i & 3); }

struct Unit { int pm, pn, g; };
struct Gemm { const bf16_t* A; const bf16_t* Bt; int K, lda, ldb; size_t gsA, gsB; };

struct StaticOrder {
    int nM, nN, nwg, G, c;
    __device__ void init(int M, int N, int G_, int c_) { nM = M / BM; nN = N / BM; nwg = nM * nN; G = G_; c = c_; }
    __device__ bool next(int i, Unit& u) const {
        const long L = (long)i * G + c; if (L >= nwg) return false;
        int wgid = (int)L; { const int q = nwg / NXCD, r = nwg % NXCD, xcd = wgid % NXCD, off = wgid / NXCD; wgid = (xcd < r ? xcd * (q + 1) : r * (q + 1) + (xcd - r) * q) + off; }
        const int nig = WGM * nN, gid = wgid / nig, fm = gid * WGM, gsz = (nM - fm) < WGM ? (nM - fm) : WGM;
        u.pm = fm + ((wgid % nig) % gsz); u.pn = (wgid % nig) / gsz; u.g = 0; return true;
    }
};
struct GroupOrder {
    int nM, upg, total, G, c;
    __device__ void init(int nM_, int nN_, int ngroups, int G_, int c_) { nM = nM_; upg = nM_ * nN_; total = upg * ngroups; G = G_; c = c_; }
    __device__ bool next(int i, Unit& u) const {
        const long L = (long)i * G + c; if (L >= total) return false;
        const int l = (int)L; u.g = l / upg; const int w = l % upg; u.pm = w % nM; u.pn = w / nM; return true;
    }
};

__device__ __forceinline__ unsigned cvt_pk_bf16(float lo, float hi) { unsigned r; asm volatile("v_cvt_pk_bf16_f32 %0, %1, %2" : "=v"(r) : "v"(lo), "v"(hi)); return r; }
__device__ __forceinline__ u32x4 pack8(f32x4 a, f32x4 b) { u32x4 w; w.x = cvt_pk_bf16(a[0], a[1]); w.y = cvt_pk_bf16(a[2], a[3]); w.z = cvt_pk_bf16(b[0], b[1]); w.w = cvt_pk_bf16(b[2], b[3]); return w; }
__device__ __forceinline__ void unpack8(u32x4 w, f32x4& a, f32x4& b) {
    a[0] = __uint_as_float(w.x << 16); a[1] = __uint_as_float(w.x & 0xffff0000u); a[2] = __uint_as_float(w.y << 16); a[3] = __uint_as_float(w.y & 0xffff0000u);
    b[0] = __uint_as_float(w.z << 16); b[1] = __uint_as_float(w.z & 0xffff0000u); b[2] = __uint_as_float(w.w << 16); b[3] = __uint_as_float(w.w & 0xffff0000u); }

template <class Epi, class Sched, bool ALIGN_EPI>
__device__ __forceinline__ void gemm_phase(PG8_LAS unsigned char* lds, const Gemm g, const Sched& S, const Epi& E) {
    int tid_ = threadIdx.x; asm volatile("" : "+v"(tid_));
    const int tid = tid_, wid = __builtin_amdgcn_readfirstlane(tid >> 6), lane = tid & 63, wr = wid >> 2, wc = wid & 3, fr = lane & 15, fq = lane >> 4;
    const int K = g.K, nt = K / BK;
    unsigned voffA[2], voffB[2];
#pragma unroll
    for (int i = 0; i < 2; ++i) { int R, C; stage_rc(tid * 16 + i * 8192, R, C); const int Rb = (R & ~31) + perm32(R & 31);
        voffA[i] = (unsigned)(R * g.lda + C) * 2u; voffB[i] = (unsigned)(Rb * g.ldb + C) * 2u; }
    const size_t kstep = (size_t)(BK * 2);
    const size_t hsA = (size_t)HALF * g.lda * 2, hsB = (size_t)HALF * g.ldb * 2;
    const size_t tsA = 2 * hsA, tsB = 2 * hsB;
    const unsigned ldsw = (unsigned)wid * 1024u;
    const int aoff = lds_byte(wr * 64 + fr, fq * 8), boff = lds_byte(wc * 32 + fr, fq * 8);
#define PG8_SA(b, h) (((b) * 2 + (h)) * HTB)
#define PG8_SB(b, h) ((4 + (b) * 2 + (h)) * HTB)
#define PG8_STAGE(bufoff, gbase, voff) do { _Pragma("unroll") for (int _i = 0; _i < 2; ++_i) \
        __builtin_amdgcn_global_load_lds((const unsigned*)((const char*)(gbase) + (voff)[_i]), (PG8_LAS unsigned*)(lds + (bufoff) + ldsw + _i * 8192), 16, 0, 0); } while (0)
#define PG8_LDA(dst, b, h) do { _Pragma("unroll") for (int m = 0; m < 4; ++m) _Pragma("unroll") for (int k = 0; k < 2; ++k) dst[m][k] = *(const PG8_LAS bf16x8*)(lds + PG8_SA(b, h) + aoff + m * 2048 + k * 1024); } while (0)
#define PG8_LDB(dst, b, h) do { _Pragma("unroll") for (int n = 0; n < 2; ++n) _Pragma("unroll") for (int k = 0; k < 2; ++k) dst[n][k] = *(const PG8_LAS bf16x8*)(lds + PG8_SB(b, h) + boff + n * 2048 + k * 1024); } while (0)
#define PG8_MMA(ai, bj, At, Bt) do { __builtin_amdgcn_s_setprio(1); _Pragma("unroll") for (int m = 0; m < 4; ++m) _Pragma("unroll") for (int n = 0; n < 2; ++n) _Pragma("unroll") for (int k = 0; k < 2; ++k) \
        acc[ai][bj][m][n] = __builtin_amdgcn_mfma_f32_16x16x32_bf16(Bt[n][k], At[m][k], acc[ai][bj][m][n], 0, 0, 0); __builtin_amdgcn_s_setprio(0); } while (0)
#define PG8_WAIT_V(n) asm volatile("s_waitcnt vmcnt(" #n ")" ::: "memory")
#define PG8_WAIT_L(n) asm volatile("s_waitcnt lgkmcnt(" #n ")" ::: "memory")
#define PG8_BAR __builtin_amdgcn_s_barrier()
#define PG8_SCHED __builtin_amdgcn_sched_barrier(0)
    Unit cur, nxt; int ui = 0;
    if (!S.next(0, cur)) return;
    f32x4 acc[2][2][4][2];
#pragma unroll
    for (int a = 0; a < 2; ++a)
#pragma unroll
        for (int b = 0; b < 2; ++b)
#pragma unroll
            for (int m = 0; m < 4; ++m)
#pragma unroll
                for (int n = 0; n < 2; ++n) acc[a][b][m][n] = (f32x4){0.f, 0.f, 0.f, 0.f};
    bf16x8 At[4][2], B0[2][2], B1[2][2];
    const char* cA = (const char*)g.A + (size_t)cur.g * g.gsA + (size_t)cur.pm * tsA; const char* cB = (const char*)g.Bt + (size_t)cur.g * g.gsB + (size_t)cur.pn * tsB;
    PG8_STAGE(PG8_SB(0, 0), cB, voffB); PG8_STAGE(PG8_SB(0, 1), cB + hsB, voffB); PG8_STAGE(PG8_SA(0, 0), cA, voffA); PG8_STAGE(PG8_SA(0, 1), cA + hsA, voffA);
    if (wr == 1) PG8_BAR;
    PG8_WAIT_V(2); PG8_BAR;
    PG8_STAGE(PG8_SB(1, 0), cB + kstep, voffB); PG8_STAGE(PG8_SA(1, 0), cA + kstep, voffA); PG8_STAGE(PG8_SB(1, 1), cB + hsB + kstep, voffB);
    PG8_WAIT_V(6); PG8_BAR;
    for (;;) {
        const bool has_next = S.next(ui + 1, nxt);
        const char* nA = has_next ? (const char*)g.A + (size_t)nxt.g * g.gsA + (size_t)nxt.pm * tsA : cA; const char* nB = has_next ? (const char*)g.Bt + (size_t)nxt.g * g.gsB + (size_t)nxt.pn * tsB : cB;
        for (int t = 0; t < nt; t += 2) {
            const bool last = (t == nt - 2);
            const char* a1 = cA + (size_t)(t + 1) * kstep;
            const char* a2 = last ? nA : cA + (size_t)(t + 2) * kstep; const char* b2 = last ? nB : cB + (size_t)(t + 2) * kstep;
            const char* a3 = a2 + kstep; const char* b3 = b2 + kstep;
            PG8_LDB(B0, 0, 0); PG8_LDB(B1, 0, 1); PG8_SCHED; PG8_LDA(At, 0, 0); PG8_STAGE(PG8_SA(1, 1), a1 + hsA, voffA);
            PG8_WAIT_V(8); PG8_WAIT_L(0); PG8_BAR; PG8_MMA(0, 0, At, B0); PG8_MMA(0, 1, At, B1); PG8_BAR; PG8_SCHED;
            PG8_LDA(At, 0, 1); PG8_STAGE(PG8_SB(0, 0), b2, voffB); PG8_STAGE(PG8_SB(0, 1), b2 + hsB, voffB); PG8_STAGE(PG8_SA(0, 0), a2, voffA);
            PG8_WAIT_V(8); PG8_WAIT_L(0); PG8_BAR; PG8_MMA(1, 0, At, B0); PG8_MMA(1, 1, At, B1); PG8_BAR; PG8_SCHED;
            PG8_LDB(B0, 1, 0); PG8_LDB(B1, 1, 1); PG8_SCHED; PG8_LDA(At, 1, 0); PG8_STAGE(PG8_SA(0, 1), a2 + hsA, voffA);
            PG8_WAIT_V(8); PG8_WAIT_L(0); PG8_BAR; PG8_MMA(0, 0, At, B0); PG8_MMA(0, 1, At, B1); PG8_BAR; PG8_SCHED;
            PG8_LDA(At, 1, 1); PG8_STAGE(PG8_SB(1, 0), b3, voffB); PG8_STAGE(PG8_SB(1, 1), b3 + hsB, voffB); PG8_STAGE(PG8_SA(1, 0), a3, voffA);
            PG8_WAIT_V(8); PG8_WAIT_L(0); PG8_BAR; PG8_MMA(1, 0, At, B0); PG8_MMA(1, 1, At, B1); PG8_BAR; PG8_SCHED;
        }
        if constexpr (ALIGN_EPI) { if (wr == 0) PG8_BAR; }
        E(acc, cur, wr, wc, fr, fq);
        if (!has_next) break;
#pragma unroll
        for (int a = 0; a < 2; ++a)
#pragma unroll
            for (int b = 0; b < 2; ++b)
#pragma unroll
                for (int m = 0; m < 4; ++m)
#pragma unroll
                    for (int n = 0; n < 2; ++n) acc[a][b][m][n] = (f32x4){0.f, 0.f, 0.f, 0.f};
        cur = nxt; cA = nA; cB = nB; ++ui;
        if constexpr (ALIGN_EPI) { if (wr == 1) PG8_BAR; }
    }
    PG8_WAIT_V(0);
    if constexpr (!ALIGN_EPI) { if (wr == 0) PG8_BAR; }
    PG8_BAR;
#undef PG8_SA
#undef PG8_SB
#undef PG8_STAGE
#undef PG8_LDA
#undef PG8_LDB
#undef PG8_MMA
#undef PG8_WAIT_V
#undef PG8_WAIT_L
#undef PG8_BAR
#undef PG8_SCHED
}
}

using pg8::f32x4; using pg8::u32x4; using pg8::u32x2; using pg8::bf16x8; using pg8::pack8; using pg8::unpack8; using pg8::cvt_pk_bf16;
typedef unsigned short bf16;
#define LAS __attribute__((address_space(3)))

constexpr int NB = 8, SEQ = 4096, D = 1024, FF = 4096, M = NB * SEQ;
constexpr int TCH = 32, NCH = SEQ / TCH;
constexpr int UK = TCH * 16 + 128;
constexpr float EPS = 1e-6f;

constexpr size_t MiB = 1u << 20;
constexpr size_t WS_MOD = 1 * MiB, WS_SHW = 2 * MiB, WS_ABT = 3 * MiB, WS_PART = 4 * MiB, WS_PARTV = 6 * MiB;
constexpr size_t WS_W1 = 8 * MiB, WS_W2 = 40 * MiB, WS_WCI = 72 * MiB, WS_WCO = 84 * MiB, WS_WSI = 88 * MiB, WS_WGLU = 90 * MiB, WS_WSO = 92 * MiB, WS_WGI = 94 * MiB, WS_WGO = 98 * MiB, WS_WST = 100 * MiB;
constexpr size_t WS_TOEP = 101 * MiB, WS_MST = 141 * MiB;
constexpr size_t WS_XA = 160 * MiB, WS_HID = 224 * MiB, WS_T0 = 224 * MiB, WS_T1 = 288 * MiB, WS_T2 = 352 * MiB, WS_T3 = 416 * MiB;
constexpr size_t WS_UEXT = WS_T0, WS_SEND = 304 * MiB, WS_END = 480 * MiB;
constexpr int LDS_BYTES = 147456;

struct Params { const float* in[30]; float* out; unsigned char* ws; };
#ifndef PROBE_ID
#define PROBE_ID 0
#endif
#define PROBE_K 4
#define PB(id) do { if (PROBE_ID == (id)) pr_t0 = __builtin_amdgcn_s_memrealtime(); } while (0)
#define PE(id) do { if (PROBE_ID == (id)) pr_acc += __builtin_amdgcn_s_memrealtime() - pr_t0; } while (0)

__device__ __forceinline__ float wave_sum(float v) {
#pragma unroll
    for (int o = 1; o < 64; o <<= 1) v += __shfl_xor(v, o);
    return v;
}
__device__ __forceinline__ float sum4(f32x4 a) { return (a[0] + a[1]) + (a[2] + a[3]); }
__device__ __forceinline__ float dot4(f32x4 a) { return (a[0] * a[0] + a[1] * a[1]) + (a[2] * a[2] + a[3] * a[3]); }
typedef unsigned long long u64;
constexpr float SS_SCALE = 1048576.0f;
__device__ __forceinline__ float rstd_from(u64 v) { return rsqrtf((float)v * (1.0f / (SS_SCALE * 1024.0f)) + EPS); }
__device__ __forceinline__ void ss_add(u64* p, float ss) { (void)__hip_atomic_fetch_add(p, (u64)(ss * SS_SCALE), __ATOMIC_RELAXED, __HIP_MEMORY_SCOPE_AGENT); }
__device__ __forceinline__ float sigmoid_f(float x) { return __builtin_amdgcn_rcpf(1.0f + __builtin_amdgcn_exp2f(-1.4426950408889634f * x)); }
__device__ __forceinline__ float gelu_tanh_f(float y) { const float t = 0.7978845608028654f * (y + 0.044715f * y * y * y); return y * sigmoid_f(2.0f * t); }


#define XB_TMO      128
#define XB_XCNT(j)  (256  + 64 * (j))
#define XB_XSUB(j)  (1280 + 64 * (j))
#define XB_XGEN(j)  (2304 + 64 * (j))
#define XB_TOP      3328
#define XB_TOPGEN   3392
#define XCD_BAR_WORDS 3456
#define XB_SPIN_CAP (1u << 18)
__device__ __forceinline__ unsigned xb_ld(unsigned* p)              { return __hip_atomic_load(p, __ATOMIC_RELAXED, __HIP_MEMORY_SCOPE_AGENT); }
__device__ __forceinline__ unsigned xb_add(unsigned* p, unsigned v) { return __hip_atomic_fetch_add(p, v, __ATOMIC_RELAXED, __HIP_MEMORY_SCOPE_AGENT); }
__device__ __forceinline__ unsigned xb_xcc_id() { return (unsigned)__builtin_amdgcn_s_getreg((3 << 11) | 20) & 0xFu; }
#define XB_SPIN(cond, bar) do { unsigned _sp = 0; while (cond) { __builtin_amdgcn_s_sleep(1); \
    if ((++_sp & 255u) == 0u) { if (xb_ld(&(bar)[XB_TMO])) break; if (_sp > XB_SPIN_CAP) { atomicAdd(&(bar)[XB_TMO], 1u); break; } } } } while (0)
struct XcdBarrier { unsigned* bar; unsigned x; volatile LAS unsigned* st; };
__device__ __forceinline__ XcdBarrier xcd_barrier_post(unsigned* bar, volatile LAS unsigned* st) {
    XcdBarrier b; b.bar = bar; b.x = xb_xcc_id(); b.st = st;
    if (threadIdx.x == 0) (void)xb_add(&bar[XB_XCNT(b.x)], 1u);
    return b;
}
__device__ __forceinline__ void xcd_barrier_complete(unsigned* bar, unsigned x, unsigned& nloc, unsigned& nx) {
    const unsigned G = gridDim.x * gridDim.y * gridDim.z;
    unsigned sum, cnt, mine, sp = 0u;
    for (;;) {
        sum = 0u; cnt = 0u; mine = 0u;
#pragma unroll
        for (unsigned j = 0; j < 16; ++j) { const unsigned c = xb_ld(&bar[XB_XCNT(j)]); sum += c; cnt += (c > 0u) ? 1u : 0u; mine = (j == x) ? c : mine; }
        if (sum == G) break;
        __builtin_amdgcn_s_sleep(1);
        if ((++sp & 255u) == 0u) { if (xb_ld(&bar[XB_TMO])) break; if (sp > XB_SPIN_CAP) { atomicAdd(&bar[XB_TMO], 1u); break; } }
    }
    nloc = mine > 0u ? mine : 1u; nx = cnt > 0u ? cnt : 1u;
}
__device__ __forceinline__ void xcd_barrier(const XcdBarrier& b) {
    asm volatile("s_waitcnt vmcnt(0)" ::: "memory");
    __syncthreads();
    if (threadIdx.x == 0) {
        unsigned* bar = b.bar;
        __builtin_amdgcn_s_waitcnt(0);
        unsigned nloc = b.st[0], nx = b.st[1];
        if (nloc == 0u) { xcd_barrier_complete(bar, b.x, nloc, nx); b.st[0] = nloc; b.st[1] = nx; }
        const unsigned old = xb_add(&bar[XB_XSUB(b.x)], 1u);
        const unsigned gen = old / nloc;
        if (old + 1u == (gen + 1u) * nloc) {
            __builtin_amdgcn_fence(__ATOMIC_RELEASE, "agent");
            asm volatile("s_waitcnt vmcnt(0)" ::: "memory");
            const unsigned og = xb_add(&bar[XB_TOP], 1u);
            const unsigned tg = og / nx;
            if (og + 1u == (tg + 1u) * nx) xb_add(&bar[XB_TOPGEN], 1u);
            else XB_SPIN(xb_ld(&bar[XB_TOPGEN]) == tg, bar);
            __builtin_amdgcn_fence(__ATOMIC_ACQUIRE, "agent");
            xb_add(&bar[XB_XGEN(b.x)], 1u);
            asm volatile("s_waitcnt vmcnt(0)" ::: "memory");
        } else {
            XB_SPIN(xb_ld(&bar[XB_XGEN(b.x)]) == gen, bar);
            __builtin_amdgcn_fence(__ATOMIC_ACQUIRE, "agent");
            asm volatile("s_waitcnt vmcnt(0)" ::: "memory");
        }
    }
    __syncthreads();
}

template <int MODE  > struct EpiIn {
    const u64* part; const float* shw; int N; bf16* O0; bf16* O1; u64* partv;
    __device__ __forceinline__ void operator()(const f32x4 (&acc)[2][2][4][2], const pg8::Unit& u, int wr, int wc, int fr, int fq) const {
        const int row0 = u.pm * 256 + wr * 64 + fr, b = u.pm >> 4, colt = u.pn * 256 + wc * 32 + 8 * fq;
        f32x4 bv[2][2]; u64 pv[2][4];
#pragma unroll
        for (int ai = 0; ai < 2; ++ai)
#pragma unroll
            for (int m = 0; m < 4; ++m) pv[ai][m] = part[row0 + ai * 128 + m * 16];
#pragma unroll
        for (int bj = 0; bj < 2; ++bj)
#pragma unroll
            for (int n = 0; n < 2; ++n) bv[bj][n] = *(const f32x4*)(shw + (size_t)b * N + colt + bj * 128 + 4 * n);
#pragma unroll
        for (int ai = 0; ai < 2; ++ai)
#pragma unroll
            for (int m = 0; m < 4; ++m) {
                const int row = row0 + ai * 128 + m * 16; const float rs = rstd_from(pv[ai][m]);
                f32x4 v[2][2];
#pragma unroll
                for (int bj = 0; bj < 2; ++bj)
#pragma unroll
                    for (int n = 0; n < 2; ++n) v[bj][n] = acc[ai][bj][m][n] * rs + bv[bj][n];
                if (MODE == 0) {
                    if (u.pn < 4) {
#pragma unroll
                        for (int bj = 0; bj < 2; ++bj) *(u32x4*)(O0 + (size_t)row * D + colt + bj * 128) = pack8(v[bj][0], v[bj][1]);
                    } else {
                        *(u32x4*)(O1 + (size_t)row * D + (u.pn - 4) * 128 + wc * 32 + 8 * fq) = pack8(v[0][0] * v[1][0], v[0][1] * v[1][1]);
                    }
                } else if (MODE == 1) {
                    const int bb = row >> 12, l = row & 4095;
#pragma unroll
                    for (int bj = 0; bj < 2; ++bj) { const int col = colt + bj * 128, gg = col >> 4, h0 = col & 15;
                        *(u32x4*)(O0 + ((size_t)gg * 1024 + bb * NCH + (l >> 5)) * UK + (l & 31) * 16 + h0) = pack8(v[bj][0], v[bj][1]); }
                } else if (MODE == 2) {
                    if (u.pn < 4) {
#pragma unroll
                        for (int bj = 0; bj < 2; ++bj) *(u32x4*)(O0 + (size_t)row * D + colt + bj * 128) = pack8(v[bj][0], v[bj][1]);
                    } else {
                        float ss = (dot4(v[0][0]) + dot4(v[0][1])) + (dot4(v[1][0]) + dot4(v[1][1]));
#pragma unroll
                        for (int bj = 0; bj < 2; ++bj) *(u32x4*)(O1 + (size_t)row * D + (colt - 1024) + bj * 128) = pack8(v[bj][0], v[bj][1]);
                        ss += __shfl_xor(ss, 16); ss += __shfl_xor(ss, 32);
                        if (fq == 0) ss_add(partv + row, ss);
                    }
                } else {
#pragma unroll
                    for (int bj = 0; bj < 2; ++bj) {
                        f32x4 r0 = __builtin_elementwise_max(v[bj][0], (f32x4){0.f, 0.f, 0.f, 0.f}), r1 = __builtin_elementwise_max(v[bj][1], (f32x4){0.f, 0.f, 0.f, 0.f});
                        *(u32x4*)(O0 + (size_t)row * FF + colt + bj * 128) = pack8(r0 * r0, r1 * r1); }
                }
            }
    }
};
struct EpiRes {
    const float* xin; float* xout; const float* gate; const float* anext; bf16* xa; u64* padd; u64* pzero;
    __device__ __forceinline__ void operator()(const f32x4 (&acc)[2][2][4][2], const pg8::Unit& u, int wr, int wc, int fr, int fq) const {
        const int row0 = u.pm * 256 + wr * 64 + fr, b = u.pm >> 4, colt = u.pn * 256 + wc * 32 + 8 * fq;
        f32x4 gv[2][2], av[2][2];
#pragma unroll
        for (int bj = 0; bj < 2; ++bj)
#pragma unroll
            for (int n = 0; n < 2; ++n) { gv[bj][n] = *(const f32x4*)(gate + b * D + colt + bj * 128 + 4 * n);
                av[bj][n] = anext ? *(const f32x4*)(anext + b * D + colt + bj * 128 + 4 * n) : (f32x4){0.f, 0.f, 0.f, 0.f}; }
#pragma unroll
        for (int ai = 0; ai < 2; ++ai)
#pragma unroll
            for (int mh = 0; mh < 2; ++mh) {
                f32x4 xo[2][2][2];
#pragma unroll
                for (int mm = 0; mm < 2; ++mm)
#pragma unroll
                    for (int bj = 0; bj < 2; ++bj) { const size_t off = (size_t)(row0 + ai * 128 + (2 * mh + mm) * 16) * D + colt + bj * 128;
                        xo[mm][bj][0] = *(const f32x4*)(xin + off); xo[mm][bj][1] = *(const f32x4*)(xin + off + 4); }
#pragma unroll
                for (int mm = 0; mm < 2; ++mm) { const int m = 2 * mh + mm, row = row0 + ai * 128 + m * 16; float ss = 0.f;
#pragma unroll
                    for (int bj = 0; bj < 2; ++bj) { const size_t off = (size_t)row * D + colt + bj * 128;
                        const f32x4 x0 = xo[mm][bj][0] + gv[bj][0] * acc[ai][bj][m][0], x1 = xo[mm][bj][1] + gv[bj][1] * acc[ai][bj][m][1];
                        *(f32x4*)(xout + off) = x0; *(f32x4*)(xout + off + 4) = x1;
                        ss += dot4(x0) + dot4(x1);
                        if (anext) *(u32x4*)(xa + off) = pack8(x0 * av[bj][0], x1 * av[bj][1]); }
                    ss += __shfl_xor(ss, 16); ss += __shfl_xor(ss, 32);
                    if (fq == 0) { ss_add(padd + row, ss); if (u.pn == 0 && wc == 0) pzero[row] = 0ull; } }
            }
    }
};
struct EpiS1 {
    float* send;
    __device__ __forceinline__ void operator()(const f32x4 (&acc)[2][2][4][2], const pg8::Unit& u, int wr, int wc, int fr, int fq) const {
        const int row0 = u.pm * 256 + wr * 64 + fr;
#pragma unroll
        for (int ai = 0; ai < 2; ++ai)
#pragma unroll
            for (int m = 0; m < 4; ++m) { float* p = send + ((size_t)u.g * 1024 + row0 + ai * 128 + m * 16) * 128 + wc * 32 + 8 * fq;
                *(f32x4*)p = acc[ai][0][m][0]; *(f32x4*)(p + 4) = acc[ai][0][m][1]; }
    }
};
struct EpiS3 {
    const bf16* uext; const float* dskip; bf16* Y;
    __device__ __forceinline__ void operator()(const f32x4 (&acc)[2][2][4][2], const pg8::Unit& u, int wr, int wc, int fr, int fq) const {
        const int row0 = u.pm * 256 + wr * 64 + fr, colt = u.pn * 256 + wc * 32 + 8 * fq, h0 = colt & 15;
        const f32x4 d0 = *(const f32x4*)(dskip + u.g * 16 + h0), d1 = *(const f32x4*)(dskip + u.g * 16 + h0 + 4);
#pragma unroll
        for (int ai = 0; ai < 2; ++ai) {
            u32x4 ur[4][2];
#pragma unroll
            for (int m = 0; m < 4; ++m)
#pragma unroll
                for (int bj = 0; bj < 2; ++bj) ur[m][bj] = *(const u32x4*)(uext + ((size_t)u.g * 1024 + row0 + ai * 128 + m * 16) * UK + colt + bj * 128);
#pragma unroll
            for (int m = 0; m < 4; ++m) { const int row = row0 + ai * 128 + m * 16;
#pragma unroll
                for (int bj = 0; bj < 2; ++bj) { const int col = colt + bj * 128, t = col >> 4;
                    f32x4 u0, u1; unpack8(ur[m][bj], u0, u1);
                    f32x4 y0 = acc[ai][bj][m][0] + d0 * u0, y1 = acc[ai][bj][m][1] + d1 * u1;
#pragma unroll
                    for (int e = 0; e < 4; ++e) { y0[e] = gelu_tanh_f(y0[e]); y1[e] = gelu_tanh_f(y1[e]); }
                    *(u32x4*)(Y + ((size_t)row * TCH + t) * D + u.g * 16 + h0) = pack8(y0, y1); } } }
    }
};
struct EpiGlu {
    const bf16* Y; const float* gb; bf16* Y2;
    __device__ __forceinline__ void operator()(const f32x4 (&acc)[2][2][4][2], const pg8::Unit& u, int wr, int wc, int fr, int fq) const {
        const int row0 = u.pm * 256 + wr * 64 + fr, colt = u.pn * 256 + wc * 32 + 8 * fq;
        f32x4 bv[2][2];
#pragma unroll
        for (int bj = 0; bj < 2; ++bj)
#pragma unroll
            for (int n = 0; n < 2; ++n) bv[bj][n] = *(const f32x4*)(gb + colt + bj * 128 + 4 * n);
#pragma unroll
        for (int ai = 0; ai < 2; ++ai) {
            u32x4 yr[4][2];
#pragma unroll
            for (int m = 0; m < 4; ++m)
#pragma unroll
                for (int bj = 0; bj < 2; ++bj) yr[m][bj] = *(const u32x4*)(Y + (size_t)(row0 + ai * 128 + m * 16) * D + colt + bj * 128);
#pragma unroll
            for (int m = 0; m < 4; ++m) { const int row = row0 + ai * 128 + m * 16;
#pragma unroll
                for (int bj = 0; bj < 2; ++bj) { const size_t off = (size_t)row * D + colt + bj * 128;
                    f32x4 y0, y1; unpack8(yr[m][bj], y0, y1);
                    f32x4 z0 = acc[ai][bj][m][0] + bv[bj][0], z1 = acc[ai][bj][m][1] + bv[bj][1];
#pragma unroll
                    for (int e = 0; e < 4; ++e) { y0[e] *= sigmoid_f(z0[e]); y1[e] *= sigmoid_f(z1[e]); }
                    *(u32x4*)(Y2 + off) = pack8(y0, y1); } } }
    }
};

__device__ __forceinline__ void transpose_item(const float* W, int K, int N, bf16* WT, int mode, LAS float* scr, int item, int lane) {
    const int nblk = N / 64, kb = item / nblk, nb = item % nblk, k0 = 64 * kb, n0 = 64 * nb;
    int drow = n0;
    if (mode == 1 && n0 >= 1024) { int nn = n0 - 1024; const int half = nn >> 10; nn &= 1023; drow = 1024 + 256 * (nn >> 7) + 128 * half + (nn & 127); }
    const int kr = lane >> 4, nc = (lane & 15) * 4;
    f32x4 v[16];
#pragma unroll
    for (int i = 0; i < 16; ++i) v[i] = *(const f32x4*)(W + (size_t)(k0 + 4 * i + kr) * N + n0 + nc);
#pragma unroll
    for (int i = 0; i < 16; ++i) { LAS float* d = scr + (4 * i + kr) * 65 + nc; d[0] = v[i][0]; d[1] = v[i][1]; d[2] = v[i][2]; d[3] = v[i][3]; }
    asm volatile("s_waitcnt lgkmcnt(0)" ::: "memory");
    const int c = lane & 7;
#pragma unroll
    for (int j = 0; j < 8; ++j) { const int n = (lane >> 3) + 8 * j; const LAS float* sp = scr + (8 * c) * 65 + n;
        u32x4 o; o.x = cvt_pk_bf16(sp[0 * 65], sp[1 * 65]); o.y = cvt_pk_bf16(sp[2 * 65], sp[3 * 65]); o.z = cvt_pk_bf16(sp[4 * 65], sp[5 * 65]); o.w = cvt_pk_bf16(sp[6 * 65], sp[7 * 65]);
        *(u32x4*)(WT + (size_t)(drow + n) * K + k0 + 8 * c) = o; }
    asm volatile("s_waitcnt lgkmcnt(0)" ::: "memory");
}

__global__ void __launch_bounds__(512, 2) mk_fwd(Params P) {
    extern __shared__ __attribute__((aligned(16))) unsigned char lds_raw[];
    cg::grid_group grid = cg::this_grid();
    LAS unsigned char* lds = (LAS unsigned char*)lds_raw;
    const int G = gridDim.x;
    const int NGW = G * 8;
#define FRESH_TID() int bid = blockIdx.x; asm volatile("" : "+s"(bid)); const int vcu = (G % 8 == 0) ? (bid % 8) * (G / 8) + bid / 8 : bid; (void)vcu; int tid = threadIdx.x; asm volatile("" : "+v"(tid)); const int lane = tid & 63, wave = __builtin_amdgcn_readfirstlane(tid >> 6); const int gw = bid * 8 + wave; (void)lane; (void)gw
    unsigned char* ws = P.ws;
    float* modv = (float*)(ws + WS_MOD); float* shw = (float*)(ws + WS_SHW); float* abt = (float*)(ws + WS_ABT);
    u64* partA = (u64*)(ws + WS_PART); u64* partB = (u64*)(ws + WS_PART + 512 * 1024); u64* partv = (u64*)(ws + WS_PARTV);
    bf16* W1t = (bf16*)(ws + WS_W1); bf16* W2t = (bf16*)(ws + WS_W2); bf16* Wci = (bf16*)(ws + WS_WCI); bf16* Wco = (bf16*)(ws + WS_WCO);
    bf16* Wsi = (bf16*)(ws + WS_WSI); bf16* Wglu = (bf16*)(ws + WS_WGLU); bf16* Wso = (bf16*)(ws + WS_WSO); bf16* Wgi = (bf16*)(ws + WS_WGI); bf16* Wgo = (bf16*)(ws + WS_WGO);
    bf16* WSt = (bf16*)(ws + WS_WST); bf16* Toep = (bf16*)(ws + WS_TOEP); bf16* Mst = (bf16*)(ws + WS_MST);
    bf16* XA = (bf16*)(ws + WS_XA); bf16* HID = (bf16*)(ws + WS_HID); bf16* T0 = (bf16*)(ws + WS_T0); bf16* T1 = (bf16*)(ws + WS_T1); bf16* T2 = (bf16*)(ws + WS_T2); bf16* T3 = (bf16*)(ws + WS_T3);
    bf16* UEXT = (bf16*)(ws + WS_UEXT); float* SEND = (float*)(ws + WS_SEND);
    float* X = P.out;
    unsigned long long pr_acc = 0, pr_t0 = 0; (void)pr_acc; (void)pr_t0;
    volatile LAS unsigned* misc = (volatile LAS unsigned*)(lds + LDS_BYTES - 64);
    if (threadIdx.x < 2) misc[threadIdx.x] = 0u;
    __syncthreads();
    const XcdBarrier xbar = xcd_barrier_post((unsigned*)ws, misc);
#define GRID_BAR() xcd_barrier(xbar)
    PB(1);

    {
    FRESH_TID();
    for (int it = bid; it < 96; it += G) {
        LAS float* cs = (LAS float*)lds; LAS float* red = cs + 8192;
        const float* c = P.in[1];
        for (int e = tid; e < 8192; e += 512) { const float v = c[e]; cs[e] = v / (1.0f + __expf(-v)); }
        __syncthreads();
        const int i = it / 24, n0 = (it % 24) * 256;
        const float* W = P.in[2] + (size_t)i * 1024 * 6144 + n0 + 4 * lane;
        f32x4 acc[8];
#pragma unroll
        for (int b = 0; b < 8; ++b) acc[b] = (f32x4){0.f, 0.f, 0.f, 0.f};
        const int k0 = wave * 128;
        for (int kk = 0; kk < 128; kk += 16) { f32x4 w[16];
#pragma unroll
            for (int k = 0; k < 16; ++k) w[k] = *(const f32x4*)(W + (size_t)(k0 + kk + k) * 6144);
#pragma unroll
            for (int k = 0; k < 16; ++k)
#pragma unroll
                for (int b = 0; b < 8; ++b) acc[b] += cs[b * 1024 + k0 + kk + k] * w[k]; }
#pragma unroll
        for (int b = 0; b < 8; ++b) *(LAS f32x4*)(red + (wave * 8 + b) * 256 + 4 * lane) = acc[b];
        __syncthreads();
#pragma unroll
        for (int j = 0; j < 4; ++j) { const int o = tid + 512 * j, b = o >> 8, nn = o & 255, n = n0 + nn, kind = n >> 10, col = n & 1023;
            float s = P.in[3][i * 6144 + n];
#pragma unroll
            for (int w = 0; w < 8; ++w) s += red[(w * 8 + b) * 256 + nn];
            if (kind == 1) s = (1.0f + s) * P.in[4][i * 1024 + col];
            if (kind == 4) s = (1.0f + s) * P.in[5][i * 1024 + col];
            const int slot = kind == 0 ? 1 : kind == 1 ? 0 : kind == 2 ? 2 : kind == 3 ? 4 : kind == 4 ? 3 : 5;
            modv[((i * 6 + slot) * 8 + b) * 1024 + col] = s; }
        __syncthreads();
    }
    for (int it = bid; it < 256; it += G) {
        const int g = it >> 2, q = it & 3;
        LAS float* pw_re = (LAS float*)lds; LAS float* pw_im = pw_re + 33 * 65; LAS float* bb_re = pw_im + 33 * 65; LAS float* bb_im = bb_re + 1024;
        LAS float* cc_re = bb_im + 1024; LAS float* cc_im = cc_re + 16 * 65; LAS float* Kd = cc_im + 16 * 65;
        __syncthreads();
        if (tid < 64) { const int p = tid;
            const float dt = expf(P.in[16][g]); const float are = P.in[14][g * 64 + p], aim = P.in[15][g * 64 + p];
            const float mag = expf(are * dt); float sn, cs_; sincosf(aim * dt, &sn, &cs_);
            const float abr = mag * cs_, abi = mag * sn, den = are * are + aim * aim, nr = abr - 1.0f, ni = abi;
            const float fre = (nr * are + ni * aim) / den, fim = (ni * are - nr * aim) / den;
            float pr = 1.0f, pi = 0.0f;
            for (int d = 0; d <= 32; ++d) { pw_re[d * 65 + p] = pr; pw_im[d * 65 + p] = pi; const float npr = pr * abr - pi * abi, npi = pr * abi + pi * abr; pr = npr; pi = npi; }
            for (int h = 0; h < 16; ++h) { const float br = P.in[17][(g * 64 + p) * 16 + h], bi = P.in[18][(g * 64 + p) * 16 + h]; bb_re[p * 16 + h] = fre * br - fim * bi; bb_im[p * 16 + h] = fre * bi + fim * br; }
            if (q == 0) { abt[(g * 64 + p) * 2] = pw_re[32 * 65 + p]; abt[(g * 64 + p) * 2 + 1] = pw_im[32 * 65 + p]; }
        }
        for (int e = tid; e < 1024; e += 512) { const int h = e >> 6, p = e & 63; cc_re[h * 65 + p] = P.in[19][g * 1024 + e]; cc_im[h * 65 + p] = P.in[20][g * 1024 + e]; }
        __syncthreads();
        { const int d = tid >> 4, h = tid & 15; float s[16];
#pragma unroll
            for (int e = 0; e < 16; ++e) s[e] = 0.f;
            for (int p = 0; p < 64; ++p) { const float cr = cc_re[h * 65 + p], ci = cc_im[h * 65 + p], pr = pw_re[d * 65 + p], pi = pw_im[d * 65 + p];
                const float wre = cr * pr - ci * pi, wim = cr * pi + ci * pr;
#pragma unroll
                for (int e = 0; e < 16; ++e) s[e] += wre * bb_re[p * 16 + e] - wim * bb_im[p * 16 + e]; }
#pragma unroll
            for (int e = 0; e < 16; ++e) Kd[(d * 16 + h) * 16 + e] = s[e]; }
        __syncthreads();
        for (int v = tid; v < 10240; v += 512) { const int rr = v / 80, kv = v % 80, n = 128 * q + rr, t = n >> 4, h = n & 15, k0 = 8 * kv;
            float val[8];
            if (k0 < 512) { const int j = k0 >> 4, h0 = k0 & 15;
#pragma unroll
                for (int e = 0; e < 8; ++e) val[e] = (j <= t) ? Kd[((t - j) * 16 + h) * 16 + h0 + e] : 0.f;
            } else { const int p0 = (k0 - 512) >> 1;
#pragma unroll
                for (int pp = 0; pp < 4; ++pp) { const int p = p0 + pp; const float cr = cc_re[h * 65 + p], ci = cc_im[h * 65 + p], pr = pw_re[(t + 1) * 65 + p], pi = pw_im[(t + 1) * 65 + p];
                    val[2 * pp] = cr * pr - ci * pi; val[2 * pp + 1] = -(cr * pi + ci * pr); } }
            u32x4 o; o.x = cvt_pk_bf16(val[0], val[1]); o.y = cvt_pk_bf16(val[2], val[3]); o.z = cvt_pk_bf16(val[4], val[5]); o.w = cvt_pk_bf16(val[6], val[7]);
            *(u32x4*)(Toep + ((size_t)g * 512 + n) * UK + k0) = o; }
        for (int v = tid; v < 4096; v += 512) { const int rr = v >> 6, kv = v & 63, n = 64 * q + rr, k0 = 8 * kv, j = k0 >> 4, h0 = k0 & 15;
            float val[8];
            if (n < 128) { const int p = n >> 1, ri = n & 1, d = 31 - j; const float pr = pw_re[d * 65 + p], pi = pw_im[d * 65 + p];
#pragma unroll
                for (int e = 0; e < 8; ++e) { const float br = bb_re[p * 16 + h0 + e], bi = bb_im[p * 16 + h0 + e]; val[e] = ri == 0 ? (pr * br - pi * bi) : (pr * bi + pi * br); }
            } else {
#pragma unroll
                for (int e = 0; e < 8; ++e) val[e] = 0.f; }
            u32x4 o; o.x = cvt_pk_bf16(val[0], val[1]); o.y = cvt_pk_bf16(val[2], val[3]); o.z = cvt_pk_bf16(val[4], val[5]); o.w = cvt_pk_bf16(val[6], val[7]);
            *(u32x4*)(Mst + ((size_t)g * 256 + n) * 512 + k0) = o; }
        __syncthreads();
    }
    for (int e = bid * 512 + tid; e < 8 * 128 * 128; e += G * 512) { const int t = (e >> 7) & 127, s = e & 127; WSt[e] = (s <= t) ? (bf16)(cvt_pk_bf16(P.in[27][e], 0.f) & 0xffffu) : (bf16)0; }
    {
        LAS float* scr = (LAS float*)(lds + wave * 16640);
        __syncthreads();
        for (int it = gw; it < 11776; it += NGW) {
            int r = it;
            if (r < 4096) { const int mt = r >> 10; transpose_item(P.in[6] + (size_t)mt * D * FF, D, FF, W1t + (size_t)mt * D * FF, 0, scr, r & 1023, lane); continue; } r -= 4096;
            if (r < 4096) { const int mt = r >> 10; transpose_item(P.in[7] + (size_t)mt * D * FF, FF, D, W2t + (size_t)mt * D * FF, 0, scr, r & 1023, lane); continue; } r -= 4096;
            if (r < 1536) { const int mt = r / 768; transpose_item(P.in[9] + (size_t)mt * D * 3072, D, 3072, Wci + (size_t)mt * D * 3072, 1, scr, r % 768, lane); continue; } r -= 1536;
            if (r < 512) { const int mt = r >> 8; transpose_item(P.in[12] + (size_t)mt * D * D, D, D, Wco + (size_t)mt * D * D, 0, scr, r & 255, lane); continue; } r -= 512;
            if (r < 256) { transpose_item(P.in[13], D, D, Wsi, 0, scr, r, lane); continue; } r -= 256;
            if (r < 256) { transpose_item(P.in[22], D, D, Wglu, 0, scr, r, lane); continue; } r -= 256;
            if (r < 256) { transpose_item(P.in[24], D, D, Wso, 0, scr, r, lane); continue; } r -= 256;
            if (r < 512) { transpose_item(P.in[25], D, 2048, Wgi, 0, scr, r, lane); continue; } r -= 512;
            transpose_item(P.in[29], D, D, Wgo, 0, scr, r, lane);
        }
    }
    }
    grid.sync();
    PE(1); PB(2);

    {
    FRESH_TID();
    for (int r = gw; r < 25600; r += NGW) {
        int start, N, layer, slot; const bf16* Wt;
        if (r < 3072) { start = 0; N = 3072; Wt = Wci; layer = 0; slot = 1; }
        else if (r < 7168) { start = 3072; N = 4096; Wt = W1t; layer = 0; slot = 4; }
        else if (r < 8192) { start = 7168; N = 1024; Wt = Wsi; layer = 1; slot = 1; }
        else if (r < 12288) { start = 8192; N = 4096; Wt = W1t + (size_t)1 * D * FF; layer = 1; slot = 4; }
        else if (r < 14336) { start = 12288; N = 2048; Wt = Wgi; layer = 2; slot = 1; }
        else if (r < 18432) { start = 14336; N = 4096; Wt = W1t + (size_t)2 * D * FF; layer = 2; slot = 4; }
        else if (r < 21504) { start = 18432; N = 3072; Wt = Wci + (size_t)D * 3072; layer = 3; slot = 1; }
        else { start = 21504; N = 4096; Wt = W1t + (size_t)3 * D * FF; layer = 3; slot = 4; }
        const int n = r - start;
        f32x4 w0, w1, w2, w3; unpack8(*(const u32x4*)(Wt + (size_t)n * D + 8 * lane), w0, w1); unpack8(*(const u32x4*)(Wt + (size_t)n * D + 512 + 8 * lane), w2, w3);
        const float* sh = modv + (size_t)((layer * 6 + slot) * 8) * 1024;
        float sv[8];
#pragma unroll
        for (int b = 0; b < 8; ++b) { const f32x4* p0 = (const f32x4*)(sh + b * 1024 + 8 * lane); const f32x4* p1 = (const f32x4*)(sh + b * 1024 + 512 + 8 * lane);
            const f32x4 t = p0[0] * w0 + p0[1] * w1 + p1[0] * w2 + p1[1] * w3; sv[b] = sum4(t); }
#pragma unroll
        for (int o = 1; o < 64; o <<= 1) {
#pragma unroll
            for (int b = 0; b < 8; ++b) sv[b] += __shfl_xor(sv[b], o); }
        if (lane < 8) { float s = sv[0];
#pragma unroll
            for (int b = 1; b < 8; ++b) s = (lane == b) ? sv[b] : s;
            shw[(size_t)8 * start + (size_t)lane * N + n] = s; }
    }
    for (int m0 = gw * 4; m0 < M; m0 += NGW * 4) {
        const f32x4* ar = (const f32x4*)(modv + (size_t)(m0 >> 12) * 1024) + lane;
        f32x4 v[4][4]; float s[4];
#pragma unroll
        for (int r = 0; r < 4; ++r)
#pragma unroll
            for (int j = 0; j < 4; ++j) v[r][j] = *((const f32x4*)(P.in[0] + (size_t)(m0 + r) * D) + lane + 64 * j);
#pragma unroll
        for (int r = 0; r < 4; ++r) { s[r] = 0.f;
#pragma unroll
            for (int j = 0; j < 4; ++j) s[r] += dot4(v[r][j]); }
#pragma unroll
        for (int o = 1; o < 64; o <<= 1) {
#pragma unroll
            for (int r = 0; r < 4; ++r) s[r] += __shfl_xor(s[r], o); }
#pragma unroll
        for (int r = 0; r < 4; ++r) {
#pragma unroll
            for (int j = 0; j < 4; ++j) { const f32x4 o = v[r][j] * ar[64 * j]; u32x2 w; w.x = cvt_pk_bf16(o[0], o[1]); w.y = cvt_pk_bf16(o[2], o[3]); *((u32x2*)(XA + (size_t)(m0 + r) * D) + lane + 64 * j) = w; }
            if (lane == 0) { partB[m0 + r] = (u64)(s[r] * SS_SCALE); partA[m0 + r] = 0ull; partv[m0 + r] = 0ull; } }
    }
    }
    GRID_BAR();
    PE(2);

#pragma unroll 1
    for (int li = 0; li < 4; ++li) {
        FRESH_TID();
        const int kind = li % 3, jm = li / 3;
        const float* mv = modv + (size_t)li * 6 * 8192;
        const int mstart = li == 0 ? 0 : li == 1 ? 7168 : li == 2 ? 12288 : 18432;
        const int fstart = li == 0 ? 3072 : li == 1 ? 8192 : li == 2 ? 14336 : 21504;
        const bf16* wout_t; const bf16* aout;
        if (kind == 0) {
            PB(6);
            {   pg8::Gemm g{XA, Wci + (size_t)jm * D * 3072, D, D, D, 0, 0}; pg8::StaticOrder S; S.init(M, 3072, G, bid);
                EpiIn<0> E{partB, shw + (size_t)8 * mstart, 3072, T0, T1, nullptr};
                pg8::gemm_phase<EpiIn<0>, pg8::StaticOrder, true>(lds, g, S, E); }
            GRID_BAR();
            PE(6); PB(8);
            {
                const float* cw = P.in[10] + (size_t)jm * 3 * D; const float* cb = P.in[11] + (size_t)jm * D;
                for (int run = bid * 4 + (tid >> 7); run < M / 32; run += G * 4) {
                    const int tok0 = run * 32, col = (tid & 127) * 8;
                    f32x4 c0a = *(const f32x4*)(cw + col), c0b = *(const f32x4*)(cw + col + 4), c1a = *(const f32x4*)(cw + D + col), c1b = *(const f32x4*)(cw + D + col + 4);
                    f32x4 c2a = *(const f32x4*)(cw + 2 * D + col), c2b = *(const f32x4*)(cw + 2 * D + col + 4), cba = *(const f32x4*)(cb + col), cbb = *(const f32x4*)(cb + col + 4);
                    f32x4 z1a = {0.f, 0.f, 0.f, 0.f}, z1b = z1a, z2a = z1a, z2b = z1a;
                    if ((tok0 & (SEQ - 1)) != 0) { unpack8(*(const u32x4*)(T1 + (size_t)(tok0 - 1) * D + col), z1a, z1b); unpack8(*(const u32x4*)(T1 + (size_t)(tok0 - 2) * D + col), z2a, z2b); }
                    for (int t0 = 0; t0 < 32; t0 += 8) { u32x4 zr[8], br[8];
#pragma unroll
                        for (int t = 0; t < 8; ++t) { const size_t off = (size_t)(tok0 + t0 + t) * D + col; zr[t] = *(const u32x4*)(T1 + off); br[t] = *(const u32x4*)(T0 + off); }
#pragma unroll
                        for (int t = 0; t < 8; ++t) { const size_t off = (size_t)(tok0 + t0 + t) * D + col;
                            f32x4 za, zb, ba, bb; unpack8(zr[t], za, zb); unpack8(br[t], ba, bb);
                            const f32x4 oa = ba * (c0a * z2a + c1a * z1a + c2a * za + cba), ob = bb * (c0b * z2b + c1b * z1b + c2b * zb + cbb);
                            *(u32x4*)(T2 + off) = pack8(oa, ob);
                            z2a = z1a; z2b = z1b; z1a = za; z1b = zb; } }
                }
            }
            GRID_BAR();
            PE(8);
            wout_t = Wco + (size_t)jm * D * D; aout = T2;
        } else if (kind == 1) {
            PB(6);
            {   pg8::Gemm g{XA, Wsi, D, D, D, 0, 0}; pg8::StaticOrder S; S.init(M, D, G, bid);
                EpiIn<1> E{partB, shw + (size_t)8 * mstart, D, UEXT, nullptr, nullptr};
                pg8::gemm_phase<EpiIn<1>, pg8::StaticOrder, true>(lds, g, S, E); }
            GRID_BAR();
            PE(6); PB(7);
            {   pg8::Gemm g{UEXT, Mst, 512, UK, 512, (size_t)1024 * UK * 2, (size_t)256 * 512 * 2}; pg8::GroupOrder S; S.init(4, 1, 64, G, vcu);
                EpiS1 E{SEND};
                pg8::gemm_phase<EpiS1, pg8::GroupOrder, true>(lds, g, S, E); }
            GRID_BAR();
            for (int wg = wave * G + bid; wg < 512; wg += 8 * G) { const int b = wg & 7, g = wg >> 3, p = lane;
                const float ar = abt[(g * 64 + p) * 2], ai = abt[(g * 64 + p) * 2 + 1];
                const float* se = SEND + ((size_t)g * 1024 + b * NCH) * 128 + 2 * p;
                bf16* so = UEXT + ((size_t)g * 1024 + b * NCH) * UK + 512 + 2 * p;
                float sr = 0.f, si = 0.f;
                *(unsigned*)so = 0u;
                for (int c0 = 0; c0 < NCH; c0 += 16) { float er[16], ei[16];
#pragma unroll
                    for (int j = 0; j < 16; ++j) { const float2 e = *(const float2*)(se + (size_t)(c0 + j) * 128); er[j] = e.x; ei[j] = e.y; }
#pragma unroll
                    for (int j = 0; j < 16; ++j) { const float nr = ar * sr - ai * si + er[j], ni = ar * si + ai * sr + ei[j]; sr = nr; si = ni;
                        if (c0 + j + 1 < NCH) *(unsigned*)(so + (size_t)(c0 + j + 1) * UK) = cvt_pk_bf16(sr, si); } }
            }
            GRID_BAR();
            {   pg8::Gemm g{UEXT, Toep, UK, UK, UK, (size_t)1024 * UK * 2, (size_t)512 * UK * 2}; pg8::GroupOrder S; S.init(4, 2, 64, G, vcu);
                EpiS3 E{UEXT, P.in[21], T2};
                pg8::gemm_phase<EpiS3, pg8::GroupOrder, true>(lds, g, S, E); }
            GRID_BAR();
            {   pg8::Gemm g{T2, Wglu, D, D, D, 0, 0}; pg8::StaticOrder S; S.init(M, D, G, bid);
                EpiGlu E{T2, P.in[23], T3};
                pg8::gemm_phase<EpiGlu, pg8::StaticOrder, true>(lds, g, S, E); }
            GRID_BAR();
            PE(7);
            wout_t = Wso; aout = T3;
        } else {
            PB(6);
            {   pg8::Gemm g{XA, Wgi, D, D, D, 0, 0}; pg8::StaticOrder S; S.init(M, 2048, G, bid);
                EpiIn<2> E{partB, shw + (size_t)8 * mstart, 2048, T0, T1, partv};
                pg8::gemm_phase<EpiIn<2>, pg8::StaticOrder, true>(lds, g, S, E); }
            GRID_BAR();
            PE(6); PB(8);
            for (int cn = bid; cn < M / 128; cn += G) {
                LAS float* rstd_s = (LAS float*)lds; LAS bf16* wsA = (LAS bf16*)(lds + 1024); LAS bf16* vT = wsA + 128 * 136;
                const int wr = wave >> 1, wc = wave & 1, fr = lane & 15, fq = lane >> 4;
                __syncthreads();
                if (tid < 128) rstd_s[tid] = rstd_from(partv[cn * 128 + tid]);
                u32x4 wreg[4], vreg[4]; u32x2 ucur[2][4], unxt[2][4];
#define SG_LOAD(hd_) do { _Pragma("unroll") for (int j = 0; j < 4; ++j) { const int ch = tid + 512 * j, r = ch >> 4, c8 = (ch & 15) * 8; \
                        wreg[j] = *(const u32x4*)(WSt + (hd_) * 16384 + r * 128 + c8); vreg[j] = *(const u32x4*)(T1 + (size_t)(cn * 128 + r) * D + (hd_) * 128 + c8); } \
                    _Pragma("unroll") for (int mi = 0; mi < 2; ++mi) _Pragma("unroll") for (int ni = 0; ni < 4; ++ni) \
                        unxt[mi][ni] = *(const u32x2*)(T0 + (size_t)(cn * 128 + 32 * wr + 16 * mi + fr) * D + (hd_) * 128 + 64 * wc + 16 * ni + 4 * fq); } while (0)
                SG_LOAD(0);
                __syncthreads();
                for (int hd = 0; hd < 8; ++hd) {
#pragma unroll
                    for (int j = 0; j < 4; ++j) { const int ch = tid + 512 * j, r = ch >> 4, c8 = (ch & 15) * 8;
                        *(LAS u32x4*)(wsA + r * 136 + c8) = wreg[j];
                        f32x4 va, vb; unpack8(vreg[j], va, vb);
                        const float rs = rstd_s[r]; const f32x4 ga = *(const f32x4*)(P.in[26] + hd * 128 + c8), gb = *(const f32x4*)(P.in[26] + hd * 128 + c8 + 4);
                        va = va * rs * ga; vb = vb * rs * gb;
                        const int pc = r ^ c8;
#pragma unroll
                        for (int e = 0; e < 4; ++e) { vT[(c8 + e) * 136 + pc] = (bf16)(cvt_pk_bf16(va[e], 0.f) & 0xffffu); vT[(c8 + 4 + e) * 136 + pc] = (bf16)(cvt_pk_bf16(vb[e], 0.f) & 0xffffu); } }
#pragma unroll
                    for (int mi = 0; mi < 2; ++mi)
#pragma unroll
                        for (int ni = 0; ni < 4; ++ni) ucur[mi][ni] = unxt[mi][ni];
                    __syncthreads();
                    if (hd + 1 < 8) SG_LOAD(hd + 1);
                    f32x4 acc[2][4];
#pragma unroll
                    for (int mi = 0; mi < 2; ++mi)
#pragma unroll
                        for (int ni = 0; ni < 4; ++ni) acc[mi][ni] = (f32x4){0.f, 0.f, 0.f, 0.f};
                    for (int ks = 0; ks <= wr; ++ks) { bf16x8 a[2], bfr[4];
#pragma unroll
                        for (int mi = 0; mi < 2; ++mi) a[mi] = *(const LAS bf16x8*)(wsA + (32 * wr + 16 * mi + fr) * 136 + 32 * ks + 8 * fq);
#pragma unroll
                        for (int ni = 0; ni < 4; ++ni) { const int dh = 64 * wc + 16 * ni + fr; bfr[ni] = *(const LAS bf16x8*)(vT + dh * 136 + ((32 * ks + 8 * fq) ^ (dh & 0x78))); }
#pragma unroll
                        for (int mi = 0; mi < 2; ++mi)
#pragma unroll
                            for (int ni = 0; ni < 4; ++ni) acc[mi][ni] = __builtin_amdgcn_mfma_f32_16x16x32_bf16(bfr[ni], a[mi], acc[mi][ni], 0, 0, 0); }
#pragma unroll
                    for (int mi = 0; mi < 2; ++mi) { const int t = 32 * wr + 16 * mi + fr; const float bs = P.in[28][hd * 128 + t];
#pragma unroll
                        for (int ni = 0; ni < 4; ++ni) { const size_t off = (size_t)(cn * 128 + t) * D + hd * 128 + 64 * wc + 16 * ni + 4 * fq;
                            const u32x2 uw = ucur[mi][ni];
                            f32x4 uu; uu[0] = __uint_as_float(uw.x << 16); uu[1] = __uint_as_float(uw.x & 0xffff0000u); uu[2] = __uint_as_float(uw.y << 16); uu[3] = __uint_as_float(uw.y & 0xffff0000u);
                            const f32x4 o = uu * (acc[mi][ni] + bs); u32x2 w; w.x = cvt_pk_bf16(o[0], o[1]); w.y = cvt_pk_bf16(o[2], o[3]);
                            *(u32x2*)(T2 + off) = w; } }
                    __syncthreads();
                }
#undef SG_LOAD
            }
            GRID_BAR();
            PE(8);
            wout_t = Wgo; aout = T2;
        }
#pragma unroll 1
        for (int half = 0; half < 2; ++half) {
            if (half == 1) {
                PB(3);
                pg8::Gemm g{XA, W1t + (size_t)li * D * FF, D, D, D, 0, 0}; pg8::StaticOrder S; S.init(M, FF, G, bid);
                EpiIn<3> E{partA, shw + (size_t)8 * fstart, FF, HID, nullptr, nullptr};
                pg8::gemm_phase<EpiIn<3>, pg8::StaticOrder, true>(lds, g, S, E);
                GRID_BAR();
                PE(3);
            }
            if (half == 0) PB(5); else PB(4);
            pg8::Gemm g; g.gsA = 0; g.gsB = 0;
            if (half == 0) { g.A = aout; g.Bt = wout_t; g.K = D; g.lda = D; g.ldb = D; }
            else { g.A = HID; g.Bt = W2t + (size_t)li * D * FF; g.K = FF; g.lda = FF; g.ldb = FF; }
            pg8::StaticOrder S; S.init(M, D, G, bid);
            EpiRes E; E.xin = (li == 0 && half == 0) ? P.in[0] : X; E.xout = X; E.gate = mv + (half == 0 ? 2 : 5) * 8192;
            E.anext = half == 0 ? mv + 3 * 8192 : (li < 3 ? modv + (size_t)(li + 1) * 6 * 8192 : nullptr); E.xa = XA; E.padd = half == 0 ? partA : partB; E.pzero = half == 0 ? partB : partA;
            pg8::gemm_phase<EpiRes, pg8::StaticOrder, true>(lds, g, S, E);
            GRID_BAR();
            if (half == 0) PE(5); else PE(4);
        }
        if (PROBE_ID == 9) { PB(9); GRID_BAR(); PE(9); }
    }
    if (PROBE_ID) { if (blockIdx.x == 0) { const unsigned long long t0 = __builtin_amdgcn_s_memrealtime(); while (__builtin_amdgcn_s_memrealtime() - t0 < PROBE_K * pr_acc) __builtin_amdgcn_s_sleep(8); } GRID_BAR(); }
    PB(2);
    FRESH_TID();
    for (int m0 = gw * 4; m0 < M; m0 += NGW * 4) {
        const f32x4* gr = (const f32x4*)P.in[8] + lane;
        f32x4 v[4][4]; float s[4];
#pragma unroll
        for (int r = 0; r < 4; ++r)
#pragma unroll
            for (int j = 0; j < 4; ++j) v[r][j] = *((const f32x4*)(X + (size_t)(m0 + r) * D) + lane + 64 * j);
#pragma unroll
        for (int r = 0; r < 4; ++r) { s[r] = 0.f;
#pragma unroll
            for (int j = 0; j < 4; ++j) s[r] += dot4(v[r][j]); }
#pragma unroll
        for (int o = 1; o < 64; o <<= 1) {
#pragma unroll
            for (int r = 0; r < 4; ++r) s[r] += __shfl_xor(s[r], o); }
#pragma unroll
        for (int r = 0; r < 4; ++r) { const float rs = rsqrtf(s[r] * (1.0f / 1024.0f) + EPS);
#pragma unroll
            for (int j = 0; j < 4; ++j) *((f32x4*)(X + (size_t)(m0 + r) * D) + lane + 64 * j) = v[r][j] * rs * gr[64 * j]; }
    }
    if (PROBE_ID == 2) { GRID_BAR(); PE(2); if (blockIdx.x == 0) { const unsigned long long t0 = __builtin_amdgcn_s_memrealtime(); while (__builtin_amdgcn_s_memrealtime() - t0 < PROBE_K * pr_acc) __builtin_amdgcn_s_sleep(8); } GRID_BAR(); }
}

extern "C" void kernel_launch(void* const* d_in, const int* in_sizes, int n_in, void* d_out, int out_size, void* d_ws, size_t ws_size, hipStream_t stream) {
    static int grid = 0;
    if (grid == 0) {
        if (n_in != 30 || out_size != M * D || ws_size < WS_END) { fprintf(stderr, "kernel_launch: unexpected problem (n_in %d, out %d, ws %zu)\n", n_in, out_size, ws_size); grid = -1; return; }
        int dev = 0, cus = 0, per_cu = 0;
        hipGetDevice(&dev); hipDeviceGetAttribute(&cus, hipDeviceAttributeMultiprocessorCount, dev);
        if (hipFuncSetAttribute((const void*)mk_fwd, hipFuncAttributeMaxDynamicSharedMemorySize, LDS_BYTES) != hipSuccess) fprintf(stderr, "kernel_launch: hipFuncSetAttribute failed\n");
        if (hipOccupancyMaxActiveBlocksPerMultiprocessor(&per_cu, (const void*)mk_fwd, 512, LDS_BYTES) != hipSuccess || per_cu < 1) per_cu = 1;
        (void)hipGetLastError();
        grid = cus * per_cu; if (grid > 256) grid = 256; if (grid < 1) grid = 256;
    }
    if (grid < 0) return;
    Params p{};
    for (int i = 0; i < 30; ++i) p.in[i] = (const float*)d_in[i];
    p.out = (float*)d_out; p.ws = (unsigned char*)d_ws;
    void* args[] = {&p};
    if (hipMemsetAsync(d_ws, 0, 16384, stream) != hipSuccess) fprintf(stderr, "kernel_launch: memset of the barrier words failed\n");
    hipError_t e = hipLaunchCooperativeKernel((const void*)mk_fwd, dim3(grid), dim3(512), args, LDS_BYTES, stream);
    if (e != hipSuccess) fprintf(stderr, "cooperative launch failed: %s (grid %d)\n", hipGetErrorString(e), grid);
}
```

```cpp
#include <hip/hip_runtime.h>
#include <hip/hip_cooperative_groups.h>
#include <cstdio>
#include <cstdint>
namespace cg = cooperative_groups;

namespace pg8 {
#define PG8_LAS __attribute__((address_space(3)))
typedef unsigned short bf16_t;
typedef short bf16x8 __attribute__((ext_vector_type(8)));
typedef float f32x4 __attribute__((ext_vector_type(4)));
typedef unsigned u32x4 __attribute__((ext_vector_type(4)));
typedef unsigned u32x2 __attribute__((ext_vector_type(2)));
constexpr int BM = 256, BK = 64, HALF = 128, HTB = HALF * BK * 2, STAGE_BYTES = 8 * HTB, NXCD = 8, WGM = 8;

__host__ __device__ __forceinline__ int lds_byte(int r, int c) { const int st = (r >> 4) * 2 + (c >> 5), rr = r & 15, cc = c & 31, ob = rr * 64 + cc * 2; return st * 1024 + (ob ^ (((ob >> 9) & 1) << 5)); }
__host__ __device__ __forceinline__ void stage_rc(int b, int& R, int& C) { const int st = b / 1024, sb = b % 1024, swz = sb ^ (((sb >> 9) & 1) << 5); R = (st >> 1) * 16 + swz / 64; C = (st & 1) * 32 + (swz % 64) / 2; }
__host__ __device__ __forceinline__ int perm32(int rho) { const int n = rho >> 4, i = rho & 15; return 8 * (i >> 2) + 4 * n + (i & 3); }

struct Unit { int pm, pn, g; };
struct Gemm { const bf16_t* A; const bf16_t* Bt; int K, lda, ldb; size_t gsA, gsB; };

struct StaticOrder {
    int nM, nN, nwg, G, c;
    __device__ void init(int M, int N, int G_, int c_) { nM = M / BM; nN = N / BM; nwg = nM * nN; G = G_; c = c_; }
    __device__ bool next(int i, Unit& u) const {
        const long L = (long)i * G + c; if (L >= nwg) return false;
        int wgid = (int)L; { const int q = nwg / NXCD, r = nwg % NXCD, xcd = wgid % NXCD, off = wgid / NXCD; wgid = (xcd < r ? xcd * (q + 1) : r * (q + 1) + (xcd - r) * q) + off; }
        const int nig = WGM * nN, gid = wgid / nig, fm = gid * WGM, gsz = (nM - fm) < WGM ? (nM - fm) : WGM;
        u.pm = fm + ((wgid % nig) % gsz); u.pn = (wgid % nig) / gsz; u.g = 0; return true;
    }
};
struct GroupOrder {
    int nM, upg, total, G, c;
    __device__ void init(int nM_, int nN_, int ngroups, int G_, int c_) { nM = nM_; upg = nM_ * nN_; total = upg * ngroups; G = G_; c = c_; }
    __device__ bool next(int i, Unit& u) const {
        const long L = (long)i * G + c; if (L >= total) return false;
        const int l = (int)L; u.g = l / upg; const int w = l % upg; u.pm = w % nM; u.pn = w / nM; return true;
    }
};

__device__ __forceinline__ unsigned cvt_pk_bf16(float lo, float hi) { unsigned r; asm volatile("v_cvt_pk_bf16_f32 %0, %1, %2" : "=v"(r) : "v"(lo), "v"(hi)); return r; }
__device__ __forceinline__ u32x4 pack8(f32x4 a, f32x4 b) { u32x4 w; w.x = cvt_pk_bf16(a[0], a[1]); w.y = cvt_pk_bf16(a[2], a[3]); w.z = cvt_pk_bf16(b[0], b[1]); w.w = cvt_pk_bf16(b[2], b[3]); return w; }
__device__ __forceinline__ void unpack8(u32x4 w, f32x4& a, f32x4& b) {
    a[0] = __uint_as_float(w.x << 16); a[1] = __uint_as_float(w.x & 0xffff0000u); a[2] = __uint_as_float(w.y << 16); a[3] = __uint_as_float(w.y & 0xffff0000u);
    b[0] = __uint_as_float(w.z << 16); b[1] = __uint_as_float(w.z & 0xffff0000u); b[2] = __uint_as_float(w.w << 16); b[3] = __uint_as_float(w.w & 0xffff0000u); }

template <class Epi, class Sched, bool ALIGN_EPI>
__device__ __forceinline__ void gemm_phase(PG8_LAS unsigned char* lds, const Gemm g, const Sched& S, const Epi& E, unsigned long long& pacc, const int pon = 0) {
    int tid_ = threadIdx.x; asm volatile("" : "+v"(tid_));
    const int tid = tid_, wid = __builtin_amdgcn_readfirstlane(tid >> 6), lane = tid & 63, wr = wid >> 2, wc = wid & 3, fr = lane & 15, fq = lane >> 4;
    const int K = g.K, nt = K / BK;
    unsigned voffA[2], voffB[2];
#pragma unroll
    for (int i = 0; i < 2; ++i) { int R, C; stage_rc(tid * 16 + i * 8192, R, C); const int Rb = (R & ~31) + perm32(R & 31);
        voffA[i] = (unsigned)(R * g.lda + C) * 2u; voffB[i] = (unsigned)(Rb * g.ldb + C) * 2u; }
    const size_t kstep = (size_t)(BK * 2);
    const size_t hsA = (size_t)HALF * g.lda * 2, hsB = (size_t)HALF * g.ldb * 2;
    const size_t tsA = 2 * hsA, tsB = 2 * hsB;
    const unsigned ldsw = (unsigned)wid * 1024u;
    const int aoff = lds_byte(wr * 64 + fr, fq * 8), boff = lds_byte(wc * 32 + fr, fq * 8);
#define PG8_SA(b, h) (((b) * 2 + (h)) * HTB)
#define PG8_SB(b, h) ((4 + (b) * 2 + (h)) * HTB)
#define PG8_STAGE(bufoff, gbase, voff) do { _Pragma("unroll") for (int _i = 0; _i < 2; ++_i) \
        __builtin_amdgcn_global_load_lds((const unsigned*)((const char*)(gbase) + (voff)[_i]), (PG8_LAS unsigned*)(lds + (bufoff) + ldsw + _i * 8192), 16, 0, 0); } while (0)
#define PG8_LDA(dst, b, h) do { _Pragma("unroll") for (int m = 0; m < 4; ++m) _Pragma("unroll") for (int k = 0; k < 2; ++k) dst[m][k] = *(const PG8_LAS bf16x8*)(lds + PG8_SA(b, h) + aoff + m * 2048 + k * 1024); } while (0)
#define PG8_LDB(dst, b, h) do { _Pragma("unroll") for (int n = 0; n < 2; ++n) _Pragma("unroll") for (int k = 0; k < 2; ++k) dst[n][k] = *(const PG8_LAS bf16x8*)(lds + PG8_SB(b, h) + boff + n * 2048 + k * 1024); } while (0)
#define PG8_MMA(ai, bj, At, Bt) do { __builtin_amdgcn_s_setprio(1); _Pragma("unroll") for (int m = 0; m < 4; ++m) _Pragma("unroll") for (int n = 0; n < 2; ++n) _Pragma("unroll") for (int k = 0; k < 2; ++k) \
        acc[ai][bj][m][n] = __builtin_amdgcn_mfma_f32_16x16x32_bf16(Bt[n][k], At[m][k], acc[ai][bj][m][n], 0, 0, 0); __builtin_amdgcn_s_setprio(0); } while (0)
#define PG8_WAIT_V(n) asm volatile("s_waitcnt vmcnt(" #n ")" ::: "memory")
#define PG8_WAIT_L(n) asm volatile("s_waitcnt lgkmcnt(" #n ")" ::: "memory")
#define PG8_BAR __builtin_amdgcn_s_barrier()
#define PG8_SCHED __builtin_amdgcn_sched_barrier(0)
    Unit cur, nxt; int ui = 0;
    if (!S.next(0, cur)) return;
    f32x4 acc[2][2][4][2];
#pragma unroll
    for (int a = 0; a < 2; ++a)
#pragma unroll
        for (int b = 0; b < 2; ++b)
#pragma unroll
            for (int m = 0; m < 4; ++m)
#pragma unroll
                for (int n = 0; n < 2; ++n) acc[a][b][m][n] = (f32x4){0.f, 0.f, 0.f, 0.f};
    bf16x8 At[4][2], B0[2][2], B1[2][2];
    const char* cA = (const char*)g.A + (size_t)cur.g * g.gsA + (size_t)cur.pm * tsA; const char* cB = (const char*)g.Bt + (size_t)cur.g * g.gsB + (size_t)cur.pn * tsB;
    PG8_STAGE(PG8_SB(0, 0), cB, voffB); PG8_STAGE(PG8_SB(0, 1), cB + hsB, voffB); PG8_STAGE(PG8_SA(0, 0), cA, voffA); PG8_STAGE(PG8_SA(0, 1), cA + hsA, voffA);
    if (wr == 1) PG8_BAR;
    PG8_WAIT_V(2); PG8_BAR;
    PG8_STAGE(PG8_SB(1, 0), cB + kstep, voffB); PG8_STAGE(PG8_SA(1, 0), cA + kstep, voffA); PG8_STAGE(PG8_SB(1, 1), cB + hsB + kstep, voffB);
    PG8_WAIT_V(6); PG8_BAR;
    for (;;) {
        const bool has_next = S.next(ui + 1, nxt);
        const char* nA = has_next ? (const char*)g.A + (size_t)nxt.g * g.gsA + (size_t)nxt.pm * tsA : cA; const char* nB = has_next ? (const char*)g.Bt + (size_t)nxt.g * g.gsB + (size_t)nxt.pn * tsB : cB;
        for (int t = 0; t < nt; t += 2) {
            const bool last = (t == nt - 2);
            const char* a1 = cA + (size_t)(t + 1) * kstep;
            const char* a2 = last ? nA : cA + (size_t)(t + 2) * kstep; const char* b2 = last ? nB : cB + (size_t)(t + 2) * kstep;
            const char* a3 = a2 + kstep; const char* b3 = b2 + kstep;
            PG8_LDB(B0, 0, 0); PG8_LDB(B1, 0, 1); PG8_SCHED; PG8_LDA(At, 0, 0); PG8_STAGE(PG8_SA(1, 1), a1 + hsA, voffA);
            PG8_WAIT_V(8); PG8_WAIT_L(0); PG8_BAR; PG8_MMA(0, 0, At, B0); PG8_MMA(0, 1, At, B1); PG8_BAR; PG8_SCHED;
            PG8_LDA(At, 0, 1); PG8_STAGE(PG8_SB(0, 0), b2, voffB); PG8_STAGE(PG8_SB(0, 1), b2 + hsB, voffB); PG8_STAGE(PG8_SA(0, 0), a2, voffA);
            PG8_WAIT_V(8); PG8_WAIT_L(0); PG8_BAR; PG8_MMA(1, 0, At, B0); PG8_MMA(1, 1, At, B1); PG8_BAR; PG8_SCHED;
            PG8_LDB(B0, 1, 0); PG8_LDB(B1, 1, 1); PG8_SCHED; PG8_LDA(At, 1, 0); PG8_STAGE(PG8_SA(0, 1), a2 + hsA, voffA);
            PG8_WAIT_V(8); PG8_WAIT_L(0); PG8_BAR; PG8_MMA(0, 0, At, B0); PG8_MMA(0, 1, At, B1); PG8_BAR; PG8_SCHED;
            PG8_LDA(At, 1, 1); PG8_STAGE(PG8_SB(1, 0), b3, voffB); PG8_STAGE(PG8_SB(1, 1), b3 + hsB, voffB); PG8_STAGE(PG8_SA(1, 0), a3, voffA);
            PG8_WAIT_V(8); PG8_WAIT_L(0); PG8_BAR; PG8_MMA(1, 0, At, B0); PG8_MMA(1, 1, At, B1); PG8_BAR; PG8_SCHED;
        }
        if constexpr (ALIGN_EPI) { if (wr == 0) PG8_BAR; }
        unsigned long long pt0 = 0; if (pon) pt0 = __builtin_amdgcn_s_memrealtime();
        E(acc, cur, wr, wc, fr, fq);
        if (pon) { if (pon == 2) asm volatile("s_waitcnt vmcnt(0)" ::: "memory"); pacc += __builtin_amdgcn_s_memrealtime() - pt0; }
        if (!has_next) break;
#pragma unroll
        for (int a = 0; a < 2; ++a)
#pragma unroll
            for (int b = 0; b < 2; ++b)
#pragma unroll
                for (int m = 0; m < 4; ++m)
#pragma unroll
                    for (int n = 0; n < 2; ++n) acc[a][b][m][n] = (f32x4){0.f, 0.f, 0.f, 0.f};
        cur = nxt; cA = nA; cB = nB; ++ui;
        if constexpr (ALIGN_EPI) { if (wr == 1) PG8_BAR; }
    }
    PG8_WAIT_V(0);
    if constexpr (!ALIGN_EPI) { if (wr == 0) PG8_BAR; }
    PG8_BAR;
#undef PG8_SA
#undef PG8_SB
#undef PG8_STAGE
#undef PG8_LDA
#undef PG8_LDB
#undef PG8_MMA
#undef PG8_WAIT_V
#undef PG8_WAIT_L
#undef PG8_BAR
#undef PG8_SCHED
}
}

using pg8::f32x4; using pg8::u32x4; using pg8::u32x2; using pg8::bf16x8; using pg8::pack8; using pg8::unpack8; using pg8::cvt_pk_bf16;
typedef unsigned short bf16;
#define LAS __attribute__((address_space(3)))

constexpr int NB = 8, SEQ = 4096, D = 1024, FF = 4096, M = NB * SEQ;
constexpr int TCH = 32, NCH = SEQ / TCH;
constexpr int UK = TCH * 16 + 128;
constexpr float EPS = 1e-6f;

constexpr size_t MiB = 1u << 20;
constexpr size_t WS_MOD = 1 * MiB, WS_SHW = 2 * MiB, WS_ABT = 3 * MiB, WS_PART = 4 * MiB, WS_PARTV = 6 * MiB;
constexpr size_t WS_W1 = 8 * MiB, WS_W2 = 40 * MiB, WS_WCI = 72 * MiB, WS_WCO = 84 * MiB, WS_WSI = 88 * MiB, WS_WGLU = 90 * MiB, WS_WSO = 92 * MiB, WS_WGI = 94 * MiB, WS_WGO = 98 * MiB, WS_WST = 100 * MiB;
constexpr size_t WS_TOEP = 101 * MiB, WS_MST = 141 * MiB;
constexpr size_t WS_XB = 160 * MiB, WS_HID = 224 * MiB, WS_T0 = 224 * MiB, WS_T1 = 288 * MiB, WS_T2 = 352 * MiB, WS_T3 = 416 * MiB;
constexpr size_t WS_UEXT = WS_T0, WS_SEND = 304 * MiB, WS_END = 480 * MiB;
constexpr int LDS_BYTES = 147456;

struct Params { const float* in[30]; float* out; unsigned char* ws; };
#ifndef PROBE_ID
#define PROBE_ID 0
#endif
#define PROBE_K 4
#define PB(id) do { if (PROBE_ID == (id)) pr_t0 = __builtin_amdgcn_s_memrealtime(); } while (0)
#define PE(id) do { if (PROBE_ID == (id)) pr_acc += __builtin_amdgcn_s_memrealtime() - pr_t0; } while (0)

__device__ __forceinline__ float wave_sum(float v) {
#pragma unroll
    for (int o = 1; o < 64; o <<= 1) v += __shfl_xor(v, o);
    return v;
}
__device__ __forceinline__ float sum4(f32x4 a) { return (a[0] + a[1]) + (a[2] + a[3]); }
__device__ __forceinline__ float dot4(f32x4 a) { return (a[0] * a[0] + a[1] * a[1]) + (a[2] * a[2] + a[3] * a[3]); }
typedef unsigned long long u64;
constexpr float SS_SCALE = 1048576.0f;
__device__ __forceinline__ float rstd_from(u64 v) { return rsqrtf((float)v * (1.0f / (SS_SCALE * 1024.0f)) + EPS); }
__device__ __forceinline__ void ss_add(u64* p, float ss) { (void)__hip_atomic_fetch_add(p, (u64)(ss * SS_SCALE), __ATOMIC_RELAXED, __HIP_MEMORY_SCOPE_AGENT); }
__device__ __forceinline__ float sigmoid_f(float x) { return __builtin_amdgcn_rcpf(1.0f + __builtin_amdgcn_exp2f(-1.4426950408889634f * x)); }
__device__ __forceinline__ float gelu_tanh_f(float y) { const float t = 0.7978845608028654f * (y + 0.044715f * y * y * y); return y * sigmoid_f(2.0f * t); }


#define XB_TMO      128
#define XB_XCNT(j)  (256  + 64 * (j))
#define XB_XSUB(j)  (1280 + 64 * (j))
#define XB_XGEN(j)  (2304 + 64 * (j))
#define XB_TOP      3328
#define XB_TOPGEN   3392
#define XCD_BAR_WORDS 3456
#define XB_SPIN_CAP (1u << 18)
__device__ __forceinline__ unsigned xb_ld(unsigned* p)              { return __hip_atomic_load(p, __ATOMIC_RELAXED, __HIP_MEMORY_SCOPE_AGENT); }
__device__ __forceinline__ unsigned xb_add(unsigned* p, unsigned v) { return __hip_atomic_fetch_add(p, v, __ATOMIC_RELAXED, __HIP_MEMORY_SCOPE_AGENT); }
__device__ __forceinline__ unsigned xb_xcc_id() { return (unsigned)__builtin_amdgcn_s_getreg((3 << 11) | 20) & 0xFu; }
#define XB_SPIN(cond, bar) do { unsigned _sp = 0; while (cond) { __builtin_amdgcn_s_sleep(1); \
    if ((++_sp & 255u) == 0u) { if (xb_ld(&(bar)[XB_TMO])) break; if (_sp > XB_SPIN_CAP) { atomicAdd(&(bar)[XB_TMO], 1u); break; } } } } while (0)
struct XcdBarrier { unsigned* bar; unsigned x; volatile LAS unsigned* st; };
__device__ __forceinline__ XcdBarrier xcd_barrier_post(unsigned* bar, volatile LAS unsigned* st) {
    XcdBarrier b; b.bar = bar; b.x = xb_xcc_id(); b.st = st;
    if (threadIdx.x == 0) (void)xb_add(&bar[XB_XCNT(b.x)], 1u);
    return b;
}
__device__ __forceinline__ void xcd_barrier_complete(unsigned* bar, unsigned x, unsigned& nloc, unsigned& nx) {
    const unsigned G = gridDim.x * gridDim.y * gridDim.z;
    unsigned sum, cnt, mine, sp = 0u;
    for (;;) {
        sum = 0u; cnt = 0u; mine = 0u;
#pragma unroll
        for (unsigned j = 0; j < 16; ++j) { const unsigned c = xb_ld(&bar[XB_XCNT(j)]); sum += c; cnt += (c > 0u) ? 1u : 0u; mine = (j == x) ? c : mine; }
        if (sum == G) break;
        __builtin_amdgcn_s_sleep(1);
        if ((++sp & 255u) == 0u) { if (xb_ld(&bar[XB_TMO])) break; if (sp > XB_SPIN_CAP) { atomicAdd(&bar[XB_TMO], 1u); break; } }
    }
    nloc = mine > 0u ? mine : 1u; nx = cnt > 0u ? cnt : 1u;
}
__device__ __forceinline__ void xcd_barrier(const XcdBarrier& b) {
    asm volatile("s_waitcnt vmcnt(0)" ::: "memory");
    __syncthreads();
    if (threadIdx.x == 0) {
        unsigned* bar = b.bar;
        __builtin_amdgcn_s_waitcnt(0);
        unsigned nloc = b.st[0], nx = b.st[1];
        if (nloc == 0u) { xcd_barrier_complete(bar, b.x, nloc, nx); b.st[0] = nloc; b.st[1] = nx; }
        const unsigned old = xb_add(&bar[XB_XSUB(b.x)], 1u);
        const unsigned gen = old / nloc;
        if (old + 1u == (gen + 1u) * nloc) {
            __builtin_amdgcn_fence(__ATOMIC_RELEASE, "agent");
            asm volatile("s_waitcnt vmcnt(0)" ::: "memory");
            const unsigned og = xb_add(&bar[XB_TOP], 1u);
            const unsigned tg = og / nx;
            if (og + 1u == (tg + 1u) * nx) xb_add(&bar[XB_TOPGEN], 1u);
            else XB_SPIN(xb_ld(&bar[XB_TOPGEN]) == tg, bar);
            __builtin_amdgcn_fence(__ATOMIC_ACQUIRE, "agent");
            xb_add(&bar[XB_XGEN(b.x)], 1u);
            asm volatile("s_waitcnt vmcnt(0)" ::: "memory");
        } else {
            XB_SPIN(xb_ld(&bar[XB_XGEN(b.x)]) == gen, bar);
            __builtin_amdgcn_fence(__ATOMIC_ACQUIRE, "agent");
            asm volatile("s_waitcnt vmcnt(0)" ::: "memory");
        }
    }
    __syncthreads();
}

template <int MODE  > struct EpiIn {
    const u64* part; const float* shw; int N; bf16* O0; bf16* O1; u64* partv;
    __device__ __forceinline__ void operator()(const f32x4 (&acc)[2][2][4][2], const pg8::Unit& u, int wr, int wc, int fr, int fq) const {
        const int row0 = u.pm * 256 + wr * 64 + fr, b = u.pm >> 4, colt = u.pn * 256 + wc * 32 + 8 * fq;
        f32x4 bv[2][2]; u64 pv[2][4];
#pragma unroll
        for (int ai = 0; ai < 2; ++ai)
#pragma unroll
            for (int m = 0; m < 4; ++m) pv[ai][m] = part[row0 + ai * 128 + m * 16];
#pragma unroll
        for (int bj = 0; bj < 2; ++bj)
#pragma unroll
            for (int n = 0; n < 2; ++n) bv[bj][n] = *(const f32x4*)(shw + (size_t)b * N + colt + bj * 128 + 4 * n);
#pragma unroll
        for (int ai = 0; ai < 2; ++ai)
#pragma unroll
            for (int m = 0; m < 4; ++m) {
                const int row = row0 + ai * 128 + m * 16; const float rs = rstd_from(pv[ai][m]);
                f32x4 v[2][2];
#pragma unroll
                for (int bj = 0; bj < 2; ++bj)
#pragma unroll
                    for (int n = 0; n < 2; ++n) v[bj][n] = acc[ai][bj][m][n] * rs + bv[bj][n];
                if (MODE == 0) {
                    if (u.pn < 4) {
#pragma unroll
                        for (int bj = 0; bj < 2; ++bj) *(u32x4*)(O0 + (size_t)row * D + colt + bj * 128) = pack8(v[bj][0], v[bj][1]);
                    } else {
                        *(u32x4*)(O1 + (size_t)row * D + (u.pn - 4) * 128 + wc * 32 + 8 * fq) = pack8(v[0][0] * v[1][0], v[0][1] * v[1][1]);
                    }
                } else if (MODE == 1) {
                    const int bb = row >> 12, l = row & 4095;
#pragma unroll
                    for (int bj = 0; bj < 2; ++bj) { const int col = colt + bj * 128, gg = col >> 4, h0 = col & 15;
                        *(u32x4*)(O0 + ((size_t)gg * 1024 + bb * NCH + (l >> 5)) * UK + (l & 31) * 16 + h0) = pack8(v[bj][0], v[bj][1]); }
                } else if (MODE == 2) {
                    if (u.pn < 4) {
#pragma unroll
                        for (int bj = 0; bj < 2; ++bj) *(u32x4*)(O0 + (size_t)row * D + colt + bj * 128) = pack8(v[bj][0], v[bj][1]);
                    } else {
                        float ss = (dot4(v[0][0]) + dot4(v[0][1])) + (dot4(v[1][0]) + dot4(v[1][1]));
#pragma unroll
                        for (int bj = 0; bj < 2; ++bj) *(u32x4*)(O1 + (size_t)row * D + (colt - 1024) + bj * 128) = pack8(v[bj][0], v[bj][1]);
                        ss += __shfl_xor(ss, 16); ss += __shfl_xor(ss, 32);
                        if (fq == 0) ss_add(partv + row, ss);
                    }
                } else {
#pragma unroll
                    for (int bj = 0; bj < 2; ++bj) {
                        f32x4 r0 = __builtin_elementwise_max(v[bj][0], (f32x4){0.f, 0.f, 0.f, 0.f}), r1 = __builtin_elementwise_max(v[bj][1], (f32x4){0.f, 0.f, 0.f, 0.f});
                        *(u32x4*)(O0 + (size_t)row * FF + colt + bj * 128) = pack8(r0 * r0, r1 * r1); }
                }
            }
    }
};
struct EpiRes {
    const bf16* xin; bf16* xout; const float* gate; const float* anext; bf16* xa; u64* padd; u64* pzero;
    __device__ __forceinline__ void operator()(const f32x4 (&acc)[2][2][4][2], const pg8::Unit& u, int wr, int wc, int fr, int fq) const {
        const int row0 = u.pm * 256 + wr * 64 + fr, b = u.pm >> 4, colt = u.pn * 256 + wc * 32 + 8 * fq;
        f32x4 gv[2][2], av[2][2];
#pragma unroll
        for (int bj = 0; bj < 2; ++bj)
#pragma unroll
            for (int n = 0; n < 2; ++n) { gv[bj][n] = *(const f32x4*)(gate + b * D + colt + bj * 128 + 4 * n);
                av[bj][n] = anext ? *(const f32x4*)(anext + b * D + colt + bj * 128 + 4 * n) : (f32x4){0.f, 0.f, 0.f, 0.f}; }
#pragma unroll
        for (int ai = 0; ai < 2; ++ai) {
            u32x4 xr[4][2];
#pragma unroll
            for (int m = 0; m < 4; ++m)
#pragma unroll
                for (int bj = 0; bj < 2; ++bj) xr[m][bj] = *(const u32x4*)(xin + (size_t)(row0 + ai * 128 + m * 16) * D + colt + bj * 128);
#pragma unroll
            for (int m = 0; m < 4; ++m) { const int row = row0 + ai * 128 + m * 16; float ss = 0.f;
#pragma unroll
                for (int bj = 0; bj < 2; ++bj) { const size_t off = (size_t)row * D + colt + bj * 128;
                    f32x4 x0, x1; unpack8(xr[m][bj], x0, x1);
                    x0 = x0 + gv[bj][0] * acc[ai][bj][m][0]; x1 = x1 + gv[bj][1] * acc[ai][bj][m][1];
                    *(u32x4*)(xout + off) = pack8(x0, x1);
                    ss += dot4(x0) + dot4(x1);
                    if (anext) *(u32x4*)(xa + off) = pack8(x0 * av[bj][0], x1 * av[bj][1]); }
                ss += __shfl_xor(ss, 16); ss += __shfl_xor(ss, 32);
                if (fq == 0) { ss_add(padd + row, ss); if (u.pn == 0 && wc == 0) pzero[row] = 0ull; } }
        }
    }
};
struct EpiS1 {
    float* send;
    __device__ __forceinline__ void operator()(const f32x4 (&acc)[2][2][4][2], const pg8::Unit& u, int wr, int wc, int fr, int fq) const {
        const int row0 = u.pm * 256 + wr * 64 + fr;
#pragma unroll
        for (int ai = 0; ai < 2; ++ai)
#pragma unroll
            for (int m = 0; m < 4; ++m) { float* p = send + ((size_t)u.g * 1024 + row0 + ai * 128 + m * 16) * 128 + wc * 32 + 8 * fq;
                *(f32x4*)p = acc[ai][0][m][0]; *(f32x4*)(p + 4) = acc[ai][0][m][1]; }
    }
};
struct EpiS3 {
    const bf16* uext; const float* dskip; bf16* Y;
    __device__ __forceinline__ void operator()(const f32x4 (&acc)[2][2][4][2], const pg8::Unit& u, int wr, int wc, int fr, int fq) const {
        const int row0 = u.pm * 256 + wr * 64 + fr, colt = u.pn * 256 + wc * 32 + 8 * fq, h0 = colt & 15;
        const f32x4 d0 = *(const f32x4*)(dskip + u.g * 16 + h0), d1 = *(const f32x4*)(dskip + u.g * 16 + h0 + 4);
#pragma unroll
        for (int ai = 0; ai < 2; ++ai) {
            u32x4 ur[4][2];
#pragma unroll
            for (int m = 0; m < 4; ++m)
#pragma unroll
                for (int bj = 0; bj < 2; ++bj) ur[m][bj] = *(const u32x4*)(uext + ((size_t)u.g * 1024 + row0 + ai * 128 + m * 16) * UK + colt + bj * 128);
#pragma unroll
            for (int m = 0; m < 4; ++m) { const int row = row0 + ai * 128 + m * 16;
#pragma unroll
                for (int bj = 0; bj < 2; ++bj) { const int col = colt + bj * 128, t = col >> 4;
                    f32x4 u0, u1; unpack8(ur[m][bj], u0, u1);
                    f32x4 y0 = acc[ai][bj][m][0] + d0 * u0, y1 = acc[ai][bj][m][1] + d1 * u1;
#pragma unroll
                    for (int e = 0; e < 4; ++e) { y0[e] = gelu_tanh_f(y0[e]); y1[e] = gelu_tanh_f(y1[e]); }
                    *(u32x4*)(Y + ((size_t)row * TCH + t) * D + u.g * 16 + h0) = pack8(y0, y1); } } }
    }
};
struct EpiGlu {
    const bf16* Y; const float* gb; bf16* Y2;
    __device__ __forceinline__ void operator()(const f32x4 (&acc)[2][2][4][2], const pg8::Unit& u, int wr, int wc, int fr, int fq) const {
        const int row0 = u.pm * 256 + wr * 64 + fr, colt = u.pn * 256 + wc * 32 + 8 * fq;
        f32x4 bv[2][2];
#pragma unroll
        for (int bj = 0; bj < 2; ++bj)
#pragma unroll
            for (int n = 0; n < 2; ++n) bv[bj][n] = *(const f32x4*)(gb + colt + bj * 128 + 4 * n);
#pragma unroll
        for (int ai = 0; ai < 2; ++ai) {
            u32x4 yr[4][2];
#pragma unroll
            for (int m = 0; m < 4; ++m)
#pragma unroll
                for (int bj = 0; bj < 2; ++bj) yr[m][bj] = *(const u32x4*)(Y + (size_t)(row0 + ai * 128 + m * 16) * D + colt + bj * 128);
#pragma unroll
            for (int m = 0; m < 4; ++m) { const int row = row0 + ai * 128 + m * 16;
#pragma unroll
                for (int bj = 0; bj < 2; ++bj) { const size_t off = (size_t)row * D + colt + bj * 128;
                    f32x4 y0, y1; unpack8(yr[m][bj], y0, y1);
                    f32x4 z0 = acc[ai][bj][m][0] + bv[bj][0], z1 = acc[ai][bj][m][1] + bv[bj][1];
#pragma unroll
                    for (int e = 0; e < 4; ++e) { y0[e] *= sigmoid_f(z0[e]); y1[e] *= sigmoid_f(z1[e]); }
                    *(u32x4*)(Y2 + off) = pack8(y0, y1); } } }
    }
};

__device__ __forceinline__ void transpose_item(const float* W, int K, int N, bf16* WT, int mode, LAS float* scr, int item, int lane) {
    const int nblk = N / 64, kb = item / nblk, nb = item % nblk, k0 = 64 * kb, n0 = 64 * nb;
    int drow = n0;
    if (mode == 1 && n0 >= 1024) { int nn = n0 - 1024; const int half = nn >> 10; nn &= 1023; drow = 1024 + 256 * (nn >> 7) + 128 * half + (nn & 127); }
    const int kr = lane >> 4, nc = (lane & 15) * 4;
    f32x4 v[16];
#pragma unroll
    for (int i = 0; i < 16; ++i) v[i] = *(const f32x4*)(W + (size_t)(k0 + 4 * i + kr) * N + n0 + nc);
#pragma unroll
    for (int i = 0; i < 16; ++i) { LAS float* d = scr + (4 * i + kr) * 65 + nc; d[0] = v[i][0]; d[1] = v[i][1]; d[2] = v[i][2]; d[3] = v[i][3]; }
    asm volatile("s_waitcnt lgkmcnt(0)" ::: "memory");
    const int c = lane & 7;
#pragma unroll
    for (int j = 0; j < 8; ++j) { const int n = (lane >> 3) + 8 * j; const LAS float* sp = scr + (8 * c) * 65 + n;
        u32x4 o; o.x = cvt_pk_bf16(sp[0 * 65], sp[1 * 65]); o.y = cvt_pk_bf16(sp[2 * 65], sp[3 * 65]); o.z = cvt_pk_bf16(sp[4 * 65], sp[5 * 65]); o.w = cvt_pk_bf16(sp[6 * 65], sp[7 * 65]);
        *(u32x4*)(WT + (size_t)(drow + n) * K + k0 + 8 * c) = o; }
    asm volatile("s_waitcnt lgkmcnt(0)" ::: "memory");
}

__global__ void __launch_bounds__(512, 2) mk_fwd(Params P) {
    extern __shared__ __attribute__((aligned(16))) unsigned char lds_raw[];
    cg::grid_group grid = cg::this_grid();
    LAS unsigned char* lds = (LAS unsigned char*)lds_raw;
    const int G = gridDim.x;
    const int NGW = G * 8;
#define FRESH_TID() int bid = blockIdx.x; asm volatile("" : "+s"(bid)); const int vcu = (G % 8 == 0) ? (bid % 8) * (G / 8) + bid / 8 : bid; (void)vcu; int tid = threadIdx.x; asm volatile("" : "+v"(tid)); const int lane = tid & 63, wave = __builtin_amdgcn_readfirstlane(tid >> 6); const int gw = bid * 8 + wave; (void)lane; (void)gw
    unsigned char* ws = P.ws;
    float* modv = (float*)(ws + WS_MOD); float* shw = (float*)(ws + WS_SHW); float* abt = (float*)(ws + WS_ABT);
    u64* partA = (u64*)(ws + WS_PART); u64* partB = (u64*)(ws + WS_PART + 512 * 1024); u64* partv = (u64*)(ws + WS_PARTV);
    bf16* W1t = (bf16*)(ws + WS_W1); bf16* W2t = (bf16*)(ws + WS_W2); bf16* Wci = (bf16*)(ws + WS_WCI); bf16* Wco = (bf16*)(ws + WS_WCO);
    bf16* Wsi = (bf16*)(ws + WS_WSI); bf16* Wglu = (bf16*)(ws + WS_WGLU); bf16* Wso = (bf16*)(ws + WS_WSO); bf16* Wgi = (bf16*)(ws + WS_WGI); bf16* Wgo = (bf16*)(ws + WS_WGO);
    bf16* WSt = (bf16*)(ws + WS_WST); bf16* Toep = (bf16*)(ws + WS_TOEP); bf16* Mst = (bf16*)(ws + WS_MST);
    bf16* XB = (bf16*)(ws + WS_XB); bf16* XA = (bf16*)P.out;     bf16* HID = (bf16*)(ws + WS_HID); bf16* T0 = (bf16*)(ws + WS_T0); bf16* T1 = (bf16*)(ws + WS_T1); bf16* T2 = (bf16*)(ws + WS_T2); bf16* T3 = (bf16*)(ws + WS_T3);
    bf16* UEXT = (bf16*)(ws + WS_UEXT); float* SEND = (float*)(ws + WS_SEND);
    unsigned long long pr_acc = 0, pr_t0 = 0; (void)pr_acc; (void)pr_t0;
    volatile LAS unsigned* misc = (volatile LAS unsigned*)(lds + LDS_BYTES - 64);
    if (threadIdx.x < 2) misc[threadIdx.x] = 0u;
    __syncthreads();
    const XcdBarrier xbar = xcd_barrier_post((unsigned*)ws, misc);
#define GRID_BAR() xcd_barrier(xbar)
    PB(1);

    {
    FRESH_TID();
    for (int it = bid; it < 96; it += G) {
        LAS float* cs = (LAS float*)lds; LAS float* red = cs + 8192;
        const float* c = P.in[1];
        for (int e = tid; e < 8192; e += 512) { const float v = c[e]; cs[e] = v / (1.0f + __expf(-v)); }
        __syncthreads();
        const int i = it / 24, n0 = (it % 24) * 256;
        const float* W = P.in[2] + (size_t)i * 1024 * 6144 + n0 + 4 * lane;
        f32x4 acc[8];
#pragma unroll
        for (int b = 0; b < 8; ++b) acc[b] = (f32x4){0.f, 0.f, 0.f, 0.f};
        const int k0 = wave * 128;
        for (int kk = 0; kk < 128; kk += 16) { f32x4 w[16];
#pragma unroll
            for (int k = 0; k < 16; ++k) w[k] = *(const f32x4*)(W + (size_t)(k0 + kk + k) * 6144);
#pragma unroll
            for (int k = 0; k < 16; ++k)
#pragma unroll
                for (int b = 0; b < 8; ++b) acc[b] += cs[b * 1024 + k0 + kk + k] * w[k]; }
#pragma unroll
        for (int b = 0; b < 8; ++b) *(LAS f32x4*)(red + (wave * 8 + b) * 256 + 4 * lane) = acc[b];
        __syncthreads();
#pragma unroll
        for (int j = 0; j < 4; ++j) { const int o = tid + 512 * j, b = o >> 8, nn = o & 255, n = n0 + nn, kind = n >> 10, col = n & 1023;
            float s = P.in[3][i * 6144 + n];
#pragma unroll
            for (int w = 0; w < 8; ++w) s += red[(w * 8 + b) * 256 + nn];
            if (kind == 1) s = (1.0f + s) * P.in[4][i * 1024 + col];
            if (kind == 4) s = (1.0f + s) * P.in[5][i * 1024 + col];
            const int slot = kind == 0 ? 1 : kind == 1 ? 0 : kind == 2 ? 2 : kind == 3 ? 4 : kind == 4 ? 3 : 5;
            modv[((i * 6 + slot) * 8 + b) * 1024 + col] = s; }
        __syncthreads();
    }
    for (int it = bid; it < 256; it += G) {
        const int g = it >> 2, q = it & 3;
        LAS float* pw_re = (LAS float*)lds; LAS float* pw_im = pw_re + 33 * 65; LAS float* bb_re = pw_im + 33 * 65; LAS float* bb_im = bb_re + 1024;
        LAS float* cc_re = bb_im + 1024; LAS float* cc_im = cc_re + 16 * 65; LAS float* Kd = cc_im + 16 * 65;
        __syncthreads();
        if (tid < 64) { const int p = tid;
            const float dt = expf(P.in[16][g]); const float are = P.in[14][g * 64 + p], aim = P.in[15][g * 64 + p];
            const float mag = expf(are * dt); float sn, cs_; sincosf(aim * dt, &sn, &cs_);
            const float abr = mag * cs_, abi = mag * sn, den = are * are + aim * aim, nr = abr - 1.0f, ni = abi;
            const float fre = (nr * are + ni * aim) / den, fim = (ni * are - nr * aim) / den;
            float pr = 1.0f, pi = 0.0f;
            for (int d = 0; d <= 32; ++d) { pw_re[d * 65 + p] = pr; pw_im[d * 65 + p] = pi; const float npr = pr * abr - pi * abi, npi = pr * abi + pi * abr; pr = npr; pi = npi; }
            for (int h = 0; h < 16; ++h) { const float br = P.in[17][(g * 64 + p) * 16 + h], bi = P.in[18][(g * 64 + p) * 16 + h]; bb_re[p * 16 + h] = fre * br - fim * bi; bb_im[p * 16 + h] = fre * bi + fim * br; }
            if (q == 0) { abt[(g * 64 + p) * 2] = pw_re[32 * 65 + p]; abt[(g * 64 + p) * 2 + 1] = pw_im[32 * 65 + p]; }
        }
        for (int e = tid; e < 1024; e += 512) { const int h = e >> 6, p = e & 63; cc_re[h * 65 + p] = P.in[19][g * 1024 + e]; cc_im[h * 65 + p] = P.in[20][g * 1024 + e]; }
        __syncthreads();
        { const int d = tid >> 4, h = tid & 15; float s[16];
#pragma unroll
            for (int e = 0; e < 16; ++e) s[e] = 0.f;
            for (int p = 0; p < 64; ++p) { const float cr = cc_re[h * 65 + p], ci = cc_im[h * 65 + p], pr = pw_re[d * 65 + p], pi = pw_im[d * 65 + p];
                const float wre = cr * pr - ci * pi, wim = cr * pi + ci * pr;
#pragma unroll
                for (int e = 0; e < 16; ++e) s[e] += wre * bb_re[p * 16 + e] - wim * bb_im[p * 16 + e]; }
#pragma unroll
            for (int e = 0; e < 16; ++e) Kd[(d * 16 + h) * 16 + e] = s[e]; }
        __syncthreads();
        for (int v = tid; v < 10240; v += 512) { const int rr = v / 80, kv = v % 80, n = 128 * q + rr, t = n >> 4, h = n & 15, k0 = 8 * kv;
            float val[8];
            if (k0 < 512) { const int j = k0 >> 4, h0 = k0 & 15;
#pragma unroll
                for (int e = 0; e < 8; ++e) val[e] = (j <= t) ? Kd[((t - j) * 16 + h) * 16 + h0 + e] : 0.f;
            } else { const int p0 = (k0 - 512) >> 1;
#pragma unroll
                for (int pp = 0; pp < 4; ++pp) { const int p = p0 + pp; const float cr = cc_re[h * 65 + p], ci = cc_im[h * 65 + p], pr = pw_re[(t + 1) * 65 + p], pi = pw_im[(t + 1) * 65 + p];
                    val[2 * pp] = cr * pr - ci * pi; val[2 * pp + 1] = -(cr * pi + ci * pr); } }
            u32x4 o; o.x = cvt_pk_bf16(val[0], val[1]); o.y = cvt_pk_bf16(val[2], val[3]); o.z = cvt_pk_bf16(val[4], val[5]); o.w = cvt_pk_bf16(val[6], val[7]);
            *(u32x4*)(Toep + ((size_t)g * 512 + n) * UK + k0) = o; }
        for (int v = tid; v < 4096; v += 512) { const int rr = v >> 6, kv = v & 63, n = 64 * q + rr, k0 = 8 * kv, j = k0 >> 4, h0 = k0 & 15;
            float val[8];
            if (n < 128) { const int p = n >> 1, ri = n & 1, d = 31 - j; const float pr = pw_re[d * 65 + p], pi = pw_im[d * 65 + p];
#pragma unroll
                for (int e = 0; e < 8; ++e) { const float br = bb_re[p * 16 + h0 + e], bi = bb_im[p * 16 + h0 + e]; val[e] = ri == 0 ? (pr * br - pi * bi) : (pr * bi + pi * br); }
            } else {
#pragma unroll
                for (int e = 0; e < 8; ++e) val[e] = 0.f; }
            u32x4 o; o.x = cvt_pk_bf16(val[0], val[1]); o.y = cvt_pk_bf16(val[2], val[3]); o.z = cvt_pk_bf16(val[4], val[5]); o.w = cvt_pk_bf16(val[6], val[7]);
            *(u32x4*)(Mst + ((size_t)g * 256 + n) * 512 + k0) = o; }
        __syncthreads();
    }
    for (int e = bid * 512 + tid; e < 8 * 128 * 128; e += G * 512) { const int t = (e >> 7) & 127, s = e & 127; WSt[e] = (s <= t) ? (bf16)(cvt_pk_bf16(P.in[27][e], 0.f) & 0xffffu) : (bf16)0; }
    {
        LAS float* scr = (LAS float*)(lds + wave * 16640);
        __syncthreads();
        for (int it = gw; it < 11776; it += NGW) {
            int r = it;
            if (r < 4096) { const int mt = r >> 10; transpose_item(P.in[6] + (size_t)mt * D * FF, D, FF, W1t + (size_t)mt * D * FF, 0, scr, r & 1023, lane); continue; } r -= 4096;
            if (r < 4096) { const int mt = r >> 10; transpose_item(P.in[7] + (size_t)mt * D * FF, FF, D, W2t + (size_t)mt * D * FF, 0, scr, r & 1023, lane); continue; } r -= 4096;
            if (r < 1536) { const int mt = r / 768; transpose_item(P.in[9] + (size_t)mt * D * 3072, D, 3072, Wci + (size_t)mt * D * 3072, 1, scr, r % 768, lane); continue; } r -= 1536;
            if (r < 512) { const int mt = r >> 8; transpose_item(P.in[12] + (size_t)mt * D * D, D, D, Wco + (size_t)mt * D * D, 0, scr, r & 255, lane); continue; } r -= 512;
            if (r < 256) { transpose_item(P.in[13], D, D, Wsi, 0, scr, r, lane); continue; } r -= 256;
            if (r < 256) { transpose_item(P.in[22], D, D, Wglu, 0, scr, r, lane); continue; } r -= 256;
            if (r < 256) { transpose_item(P.in[24], D, D, Wso, 0, scr, r, lane); continue; } r -= 256;
            if (r < 512) { transpose_item(P.in[25], D, 2048, Wgi, 0, scr, r, lane); continue; } r -= 512;
            transpose_item(P.in[29], D, D, Wgo, 0, scr, r, lane);
        }
    }
    }
    grid.sync();
    PE(1); PB(2);

    {
    FRESH_TID();
    for (int r = gw; r < 25600; r += NGW) {
        int start, N, layer, slot; const bf16* Wt;
        if (r < 3072) { start = 0; N = 3072; Wt = Wci; layer = 0; slot = 1; }
        else if (r < 7168) { start = 3072; N = 4096; Wt = W1t; layer = 0; slot = 4; }
        else if (r < 8192) { start = 7168; N = 1024; Wt = Wsi; layer = 1; slot = 1; }
        else if (r < 12288) { start = 8192; N = 4096; Wt = W1t + (size_t)1 * D * FF; layer = 1; slot = 4; }
        else if (r < 14336) { start = 12288; N = 2048; Wt = Wgi; layer = 2; slot = 1; }
        else if (r < 18432) { start = 14336; N = 4096; Wt = W1t + (size_t)2 * D * FF; layer = 2; slot = 4; }
        else if (r < 21504) { start = 18432; N = 3072; Wt = Wci + (size_t)D * 3072; layer = 3; slot = 1; }
        else { start = 21504; N = 4096; Wt = W1t + (size_t)3 * D * FF; layer = 3; slot = 4; }
        const int n = r - start;
        f32x4 w0, w1, w2, w3; unpack8(*(const u32x4*)(Wt + (size_t)n * D + 8 * lane), w0, w1); unpack8(*(const u32x4*)(Wt + (size_t)n * D + 512 + 8 * lane), w2, w3);
        const float* sh = modv + (size_t)((layer * 6 + slot) * 8) * 1024;
        float sv[8];
#pragma unroll
        for (int b = 0; b < 8; ++b) { const f32x4* p0 = (const f32x4*)(sh + b * 1024 + 8 * lane); const f32x4* p1 = (const f32x4*)(sh + b * 1024 + 512 + 8 * lane);
            const f32x4 t = p0[0] * w0 + p0[1] * w1 + p1[0] * w2 + p1[1] * w3; sv[b] = sum4(t); }
#pragma unroll
        for (int o = 1; o < 64; o <<= 1) {
#pragma unroll
            for (int b = 0; b < 8; ++b) sv[b] += __shfl_xor(sv[b], o); }
        if (lane < 8) { float s = sv[0];
#pragma unroll
            for (int b = 1; b < 8; ++b) s = (lane == b) ? sv[b] : s;
            shw[(size_t)8 * start + (size_t)lane * N + n] = s; }
    }
    for (int m0 = gw * 4; m0 < M; m0 += NGW * 4) {
        const f32x4* ar = (const f32x4*)(modv + (size_t)(m0 >> 12) * 1024) + lane;
        f32x4 v[4][4]; float s[4];
#pragma unroll
        for (int r = 0; r < 4; ++r)
#pragma unroll
            for (int j = 0; j < 4; ++j) v[r][j] = *((const f32x4*)(P.in[0] + (size_t)(m0 + r) * D) + lane + 64 * j);
#pragma unroll
        for (int r = 0; r < 4; ++r) { s[r] = 0.f;
#pragma unroll
            for (int j = 0; j < 4; ++j) s[r] += dot4(v[r][j]); }
#pragma unroll
        for (int o = 1; o < 64; o <<= 1) {
#pragma unroll
            for (int r = 0; r < 4; ++r) s[r] += __shfl_xor(s[r], o); }
#pragma unroll
        for (int r = 0; r < 4; ++r) {
#pragma unroll
            for (int j = 0; j < 4; ++j) { const f32x4 o = v[r][j] * ar[64 * j]; u32x2 w; w.x = cvt_pk_bf16(o[0], o[1]); w.y = cvt_pk_bf16(o[2], o[3]); *((u32x2*)(XA + (size_t)(m0 + r) * D) + lane + 64 * j) = w;
                u32x2 wx; wx.x = cvt_pk_bf16(v[r][j][0], v[r][j][1]); wx.y = cvt_pk_bf16(v[r][j][2], v[r][j][3]); *((u32x2*)(XB + (size_t)(m0 + r) * D) + lane + 64 * j) = wx; }
            if (lane == 0) { partB[m0 + r] = (u64)(s[r] * SS_SCALE); partA[m0 + r] = 0ull; partv[m0 + r] = 0ull; } }
    }
    }
    GRID_BAR();
    PE(2);

#pragma unroll 1
    for (int li = 0; li < 4; ++li) {
        FRESH_TID();
        const int kind = li % 3, jm = li / 3;
        const float* mv = modv + (size_t)li * 6 * 8192;
        const int mstart = li == 0 ? 0 : li == 1 ? 7168 : li == 2 ? 12288 : 18432;
        const int fstart = li == 0 ? 3072 : li == 1 ? 8192 : li == 2 ? 14336 : 21504;
        const bf16* wout_t; const bf16* aout;
        if (kind == 0) {
            PB(6);
            {   pg8::Gemm g{XA, Wci + (size_t)jm * D * 3072, D, D, D, 0, 0}; pg8::StaticOrder S; S.init(M, 3072, G, bid);
                EpiIn<0> E{partB, shw + (size_t)8 * mstart, 3072, T0, T1, nullptr};
                pg8::gemm_phase<EpiIn<0>, pg8::StaticOrder, true>(lds, g, S, E, pr_acc); }
            GRID_BAR();
            PE(6); PB(8);
            {
                const float* cw = P.in[10] + (size_t)jm * 3 * D; const float* cb = P.in[11] + (size_t)jm * D;
                for (int run = bid * 4 + (tid >> 7); run < M / 32; run += G * 4) {
                    const int tok0 = run * 32, col = (tid & 127) * 8;
                    f32x4 c0a = *(const f32x4*)(cw + col), c0b = *(const f32x4*)(cw + col + 4), c1a = *(const f32x4*)(cw + D + col), c1b = *(const f32x4*)(cw + D + col + 4);
                    f32x4 c2a = *(const f32x4*)(cw + 2 * D + col), c2b = *(const f32x4*)(cw + 2 * D + col + 4), cba = *(const f32x4*)(cb + col), cbb = *(const f32x4*)(cb + col + 4);
                    f32x4 z1a = {0.f, 0.f, 0.f, 0.f}, z1b = z1a, z2a = z1a, z2b = z1a;
                    if ((tok0 & (SEQ - 1)) != 0) { unpack8(*(const u32x4*)(T1 + (size_t)(tok0 - 1) * D + col), z1a, z1b); unpack8(*(const u32x4*)(T1 + (size_t)(tok0 - 2) * D + col), z2a, z2b); }
                    for (int t0 = 0; t0 < 32; t0 += 8) { u32x4 zr[8], br[8];
#pragma unroll
                        for (int t = 0; t < 8; ++t) { const size_t off = (size_t)(tok0 + t0 + t) * D + col; zr[t] = *(const u32x4*)(T1 + off); br[t] = *(const u32x4*)(T0 + off); }
#pragma unroll
                        for (int t = 0; t < 8; ++t) { const size_t off = (size_t)(tok0 + t0 + t) * D + col;
                            f32x4 za, zb, ba, bb; unpack8(zr[t], za, zb); unpack8(br[t], ba, bb);
                            const f32x4 oa = ba * (c0a * z2a + c1a * z1a + c2a * za + cba), ob = bb * (c0b * z2b + c1b * z1b + c2b * zb + cbb);
                            *(u32x4*)(T2 + off) = pack8(oa, ob);
                            z2a = z1a; z2b = z1b; z1a = za; z1b = zb; } }
                }
            }
            GRID_BAR();
            PE(8);
            wout_t = Wco + (size_t)jm * D * D; aout = T2;
        } else if (kind == 1) {
            PB(6);
            {   pg8::Gemm g{XA, Wsi, D, D, D, 0, 0}; pg8::StaticOrder S; S.init(M, D, G, bid);
                EpiIn<1> E{partB, shw + (size_t)8 * mstart, D, UEXT, nullptr, nullptr};
                pg8::gemm_phase<EpiIn<1>, pg8::StaticOrder, true>(lds, g, S, E, pr_acc); }
            GRID_BAR();
            PE(6); PB(7);
            {   pg8::Gemm g{UEXT, Mst, 512, UK, 512, (size_t)1024 * UK * 2, (size_t)256 * 512 * 2}; pg8::GroupOrder S; S.init(4, 1, 64, G, vcu);
                EpiS1 E{SEND};
                pg8::gemm_phase<EpiS1, pg8::GroupOrder, true>(lds, g, S, E, pr_acc); }
            GRID_BAR();
            for (int wg = wave * G + bid; wg < 512; wg += 8 * G) { const int b = wg & 7, g = wg >> 3, p = lane;
                const float ar = abt[(g * 64 + p) * 2], ai = abt[(g * 64 + p) * 2 + 1];
                const float* se = SEND + ((size_t)g * 1024 + b * NCH) * 128 + 2 * p;
                bf16* so = UEXT + ((size_t)g * 1024 + b * NCH) * UK + 512 + 2 * p;
                float sr = 0.f, si = 0.f;
                *(unsigned*)so = 0u;
                for (int c0 = 0; c0 < NCH; c0 += 16) { float er[16], ei[16];
#pragma unroll
                    for (int j = 0; j < 16; ++j) { const float2 e = *(const float2*)(se + (size_t)(c0 + j) * 128); er[j] = e.x; ei[j] = e.y; }
#pragma unroll
                    for (int j = 0; j < 16; ++j) { const float nr = ar * sr - ai * si + er[j], ni = ar * si + ai * sr + ei[j]; sr = nr; si = ni;
                        if (c0 + j + 1 < NCH) *(unsigned*)(so + (size_t)(c0 + j + 1) * UK) = cvt_pk_bf16(sr, si); } }
            }
            GRID_BAR();
            {   pg8::Gemm g{UEXT, Toep, UK, UK, UK, (size_t)1024 * UK * 2, (size_t)512 * UK * 2}; pg8::GroupOrder S; S.init(4, 2, 64, G, vcu);
                EpiS3 E{UEXT, P.in[21], T2};
                pg8::gemm_phase<EpiS3, pg8::GroupOrder, true>(lds, g, S, E, pr_acc); }
            GRID_BAR();
            {   pg8::Gemm g{T2, Wglu, D, D, D, 0, 0}; pg8::StaticOrder S; S.init(M, D, G, bid);
                EpiGlu E{T2, P.in[23], T3};
                pg8::gemm_phase<EpiGlu, pg8::StaticOrder, true>(lds, g, S, E, pr_acc); }
            GRID_BAR();
            PE(7);
            wout_t = Wso; aout = T3;
        } else {
            PB(6);
            {   pg8::Gemm g{XA, Wgi, D, D, D, 0, 0}; pg8::StaticOrder S; S.init(M, 2048, G, bid);
                EpiIn<2> E{partB, shw + (size_t)8 * mstart, 2048, T0, T1, partv};
                pg8::gemm_phase<EpiIn<2>, pg8::StaticOrder, true>(lds, g, S, E, pr_acc); }
            GRID_BAR();
            PE(6); PB(8);
            for (int cn = bid; cn < M / 128; cn += G) {
                LAS float* rstd_s = (LAS float*)lds; LAS bf16* wsA = (LAS bf16*)(lds + 1024); LAS bf16* vT = wsA + 128 * 136;
                const int wr = wave >> 1, wc = wave & 1, fr = lane & 15, fq = lane >> 4;
                __syncthreads();
                if (tid < 128) rstd_s[tid] = rstd_from(partv[cn * 128 + tid]);
                u32x4 wreg[4], vreg[4]; u32x2 ucur[2][4], unxt[2][4];
#define SG_LOAD(hd_) do { _Pragma("unroll") for (int j = 0; j < 4; ++j) { const int ch = tid + 512 * j, r = ch >> 4, c8 = (ch & 15) * 8; \
                        wreg[j] = *(const u32x4*)(WSt + (hd_) * 16384 + r * 128 + c8); vreg[j] = *(const u32x4*)(T1 + (size_t)(cn * 128 + r) * D + (hd_) * 128 + c8); } \
                    _Pragma("unroll") for (int mi = 0; mi < 2; ++mi) _Pragma("unroll") for (int ni = 0; ni < 4; ++ni) \
                        unxt[mi][ni] = *(const u32x2*)(T0 + (size_t)(cn * 128 + 32 * wr + 16 * mi + fr) * D + (hd_) * 128 + 64 * wc + 16 * ni + 4 * fq); } while (0)
                SG_LOAD(0);
                __syncthreads();
                for (int hd = 0; hd < 8; ++hd) {
#pragma unroll
                    for (int j = 0; j < 4; ++j) { const int ch = tid + 512 * j, r = ch >> 4, c8 = (ch & 15) * 8;
                        *(LAS u32x4*)(wsA + r * 136 + c8) = wreg[j];
                        f32x4 va, vb; unpack8(vreg[j], va, vb);
                        const float rs = rstd_s[r]; const f32x4 ga = *(const f32x4*)(P.in[26] + hd * 128 + c8), gb = *(const f32x4*)(P.in[26] + hd * 128 + c8 + 4);
                        va = va * rs * ga; vb = vb * rs * gb;
                        const int pc = r ^ c8;
#pragma unroll
                        for (int e = 0; e < 4; ++e) { vT[(c8 + e) * 136 + pc] = (bf16)(cvt_pk_bf16(va[e], 0.f) & 0xffffu); vT[(c8 + 4 + e) * 136 + pc] = (bf16)(cvt_pk_bf16(vb[e], 0.f) & 0xffffu); } }
#pragma unroll
                    for (int mi = 0; mi < 2; ++mi)
#pragma unroll
                        for (int ni = 0; ni < 4; ++ni) ucur[mi][ni] = unxt[mi][ni];
                    __syncthreads();
                    if (hd + 1 < 8) SG_LOAD(hd + 1);
                    f32x4 acc[2][4];
#pragma unroll
                    for (int mi = 0; mi < 2; ++mi)
#pragma unroll
                        for (int ni = 0; ni < 4; ++ni) acc[mi][ni] = (f32x4){0.f, 0.f, 0.f, 0.f};
                    for (int ks = 0; ks <= wr; ++ks) { bf16x8 a[2], bfr[4];
#pragma unroll
                        for (int mi = 0; mi < 2; ++mi) a[mi] = *(const LAS bf16x8*)(wsA + (32 * wr + 16 * mi + fr) * 136 + 32 * ks + 8 * fq);
#pragma unroll
                        for (int ni = 0; ni < 4; ++ni) { const int dh = 64 * wc + 16 * ni + fr; bfr[ni] = *(const LAS bf16x8*)(vT + dh * 136 + ((32 * ks + 8 * fq) ^ (dh & 0x78))); }
#pragma unroll
                        for (int mi = 0; mi < 2; ++mi)
#pragma unroll
                            for (int ni = 0; ni < 4; ++ni) acc[mi][ni] = __builtin_amdgcn_mfma_f32_16x16x32_bf16(bfr[ni], a[mi], acc[mi][ni], 0, 0, 0); }
#pragma unroll
                    for (int mi = 0; mi < 2; ++mi) { const int t = 32 * wr + 16 * mi + fr; const float bs = P.in[28][hd * 128 + t];
#pragma unroll
                        for (int ni = 0; ni < 4; ++ni) { const size_t off = (size_t)(cn * 128 + t) * D + hd * 128 + 64 * wc + 16 * ni + 4 * fq;
                            const u32x2 uw = ucur[mi][ni];
                            f32x4 uu; uu[0] = __uint_as_float(uw.x << 16); uu[1] = __uint_as_float(uw.x & 0xffff0000u); uu[2] = __uint_as_float(uw.y << 16); uu[3] = __uint_as_float(uw.y & 0xffff0000u);
                            const f32x4 o = uu * (acc[mi][ni] + bs); u32x2 w; w.x = cvt_pk_bf16(o[0], o[1]); w.y = cvt_pk_bf16(o[2], o[3]);
                            *(u32x2*)(T2 + off) = w; } }
                    __syncthreads();
                }
#undef SG_LOAD
            }
            GRID_BAR();
            PE(8);
            wout_t = Wgo; aout = T2;
        }
#pragma unroll 1
        for (int half = 0; half < 2; ++half) {
            if (half == 1) {
                PB(3);
                pg8::Gemm g{XA, W1t + (size_t)li * D * FF, D, D, D, 0, 0}; pg8::StaticOrder S; S.init(M, FF, G, bid);
                EpiIn<3> E{partA, shw + (size_t)8 * fstart, FF, HID, nullptr, nullptr};
                pg8::gemm_phase<EpiIn<3>, pg8::StaticOrder, true>(lds, g, S, E, pr_acc, PROBE_ID == 10 ? 2 : PROBE_ID == 13 ? 1 : 0);
                GRID_BAR();
                PE(3);
            }
            if (half == 0) PB(5); else PB(4);
            pg8::Gemm g; g.gsA = 0; g.gsB = 0;
            if (half == 0) { g.A = aout; g.Bt = wout_t; g.K = D; g.lda = D; g.ldb = D; }
            else { g.A = HID; g.Bt = W2t + (size_t)li * D * FF; g.K = FF; g.lda = FF; g.ldb = FF; }
            pg8::StaticOrder S; S.init(M, D, G, bid);
            EpiRes E; E.xin = XB; E.xout = XB; E.gate = mv + (half == 0 ? 2 : 5) * 8192;
            E.anext = half == 0 ? mv + 3 * 8192 : (li < 3 ? modv + (size_t)(li + 1) * 6 * 8192 : nullptr); E.xa = XA; E.padd = half == 0 ? partA : partB; E.pzero = half == 0 ? partB : partA;
            pg8::gemm_phase<EpiRes, pg8::StaticOrder, true>(lds, g, S, E, pr_acc, (PROBE_ID == 11 && half == 1) ? 2 : (PROBE_ID == 12 && half == 0) ? 2 : 0);
            GRID_BAR();
            if (half == 0) PE(5); else PE(4);
        }
        if (PROBE_ID == 9) { PB(9); GRID_BAR(); PE(9); }
    }
    if (PROBE_ID) { if (blockIdx.x == 0) { const unsigned long long t0 = __builtin_amdgcn_s_memrealtime(); while (__builtin_amdgcn_s_memrealtime() - t0 < PROBE_K * pr_acc) __builtin_amdgcn_s_sleep(8); } GRID_BAR(); }
    PB(2);
    FRESH_TID();
    for (int m0 = gw * 4; m0 < M; m0 += NGW * 4) {
        const f32x4* gr = (const f32x4*)P.in[8] + lane;
        u32x2 xr[4][4]; f32x4 v[4][4]; float s[4];
#pragma unroll
        for (int r = 0; r < 4; ++r)
#pragma unroll
            for (int j = 0; j < 4; ++j) xr[r][j] = *((const u32x2*)(XB + (size_t)(m0 + r) * D) + lane + 64 * j);
#pragma unroll
        for (int r = 0; r < 4; ++r) { s[r] = 0.f;
#pragma unroll
            for (int j = 0; j < 4; ++j) { const u32x2 w = xr[r][j]; v[r][j][0] = __uint_as_float(w.x << 16); v[r][j][1] = __uint_as_float(w.x & 0xffff0000u); v[r][j][2] = __uint_as_float(w.y << 16); v[r][j][3] = __uint_as_float(w.y & 0xffff0000u);
                s[r] += dot4(v[r][j]); } }
#pragma unroll
        for (int o = 1; o < 64; o <<= 1) {
#pragma unroll
            for (int r = 0; r < 4; ++r) s[r] += __shfl_xor(s[r], o); }
#pragma unroll
        for (int r = 0; r < 4; ++r) { const float rs = rsqrtf(s[r] * (1.0f / 1024.0f) + EPS);
#pragma unroll
            for (int j = 0; j < 4; ++j) *((f32x4*)(P.out + (size_t)(m0 + r) * D) + lane + 64 * j) = v[r][j] * rs * gr[64 * j]; }
    }
    if (PROBE_ID == 2) { GRID_BAR(); PE(2); if (blockIdx.x == 0) { const unsigned long long t0 = __builtin_amdgcn_s_memrealtime(); while (__builtin_amdgcn_s_memrealtime() - t0 < PROBE_K * pr_acc) __builtin_amdgcn_s_sleep(8); } GRID_BAR(); }
}

extern "C" void kernel_launch(void* const* d_in, const int* in_sizes, int n_in, void* d_out, int out_size, void* d_ws, size_t ws_size, hipStream_t stream) {
    static int grid = 0;
    if (grid == 0) {
        if (n_in != 30 || out_size != M * D || ws_size < WS_END) { fprintf(stderr, "kernel_launch: unexpected problem (n_in %d, out %d, ws %zu)\n", n_in, out_size, ws_size); grid = -1; return; }
        int dev = 0, cus = 0, per_cu = 0;
        hipGetDevice(&dev); hipDeviceGetAttribute(&cus, hipDeviceAttributeMultiprocessorCount, dev);
        if (hipFuncSetAttribute((const void*)mk_fwd, hipFuncAttributeMaxDynamicSharedMemorySize, LDS_BYTES) != hipSuccess) fprintf(stderr, "kernel_launch: hipFuncSetAttribute failed\n");
        if (hipOccupancyMaxActiveBlocksPerMultiprocessor(&per_cu, (const void*)mk_fwd, 512, LDS_BYTES) != hipSuccess || per_cu < 1) per_cu = 1;
        (void)hipGetLastError();
        grid = cus * per_cu; if (grid > 256) grid = 256; if (grid < 1) grid = 256;
    }
    if (grid < 0) return;
    Params p{};
    for (int i = 0; i < 30; ++i) p.in[i] = (const float*)d_in[i];
    p.out = (float*)d_out; p.ws = (unsigned char*)d_ws;
    void* args[] = {&p};
    if (hipMemsetAsync(d_ws, 0, 16384, stream) != hipSuccess) fprintf(stderr, "kernel_launch: memset of the barrier words failed\n");
    hipError_t e = hipLaunchCooperativeKernel((const void*)mk_fwd, dim3(grid), dim3(512), args, LDS_BYTES, stream);
    if (e != hipSuccess) fprintf(stderr, "cooperative launch failed: %s (grid %d)\n", hipGetErrorString(e), grid);
}
```

```cpp
#include <hip/hip_runtime.h>
#include <hip/hip_cooperative_groups.h>
#include <cstdio>
#include <cstdint>
namespace cg = cooperative_groups;

namespace pg8 {
#define PG8_LAS __attribute__((address_space(3)))
typedef unsigned short bf16_t;
typedef short bf16x8 __attribute__((ext_vector_type(8)));
typedef float f32x4 __attribute__((ext_vector_type(4)));
typedef unsigned u32x4 __attribute__((ext_vector_type(4)));
typedef unsigned u32x2 __attribute__((ext_vector_type(2)));
constexpr int BM = 256, BK = 64, HALF = 128, HTB = HALF * BK * 2, STAGE_BYTES = 8 * HTB, NXCD = 8, WGM = 8;

__host__ __device__ __forceinline__ int lds_byte(int r, int c) { const int st = (r >> 4) * 2 + (c >> 5), rr = r & 15, cc = c & 31, ob = rr * 64 + cc * 2; return st * 1024 + (ob ^ (((ob >> 9) & 1) << 5)); }
__host__ __device__ __forceinline__ void stage_rc(int b, int& R, int& C) { const int st = b / 1024, sb = b % 1024, swz = sb ^ (((sb >> 9) & 1) << 5); R = (st >> 1) * 16 + swz / 64; C = (st & 1) * 32 + (swz % 64) / 2; }
__host__ __device__ __forceinline__ int perm32(int rho) { const int n = rho >> 4, i = rho & 15; return 8 * (i >> 2) + 4 * n + (i & 3); }

struct Unit { int pm, pn, g; };
struct Gemm { const bf16_t* A; const bf16_t* Bt; int K, lda, ldb; size_t gsA, gsB; };

struct StaticOrder {
    int nM, nN, nwg, G, c;
    __device__ void init(int M, int N, int G_, int c_) { nM = M / BM; nN = N / BM; nwg = nM * nN; G = G_; c = c_; }
    __device__ bool next(int i, Unit& u) const {
        const long L = (long)i * G + c; if (L >= nwg) return false;
        int wgid = (int)L; { const int q = nwg / NXCD, r = nwg % NXCD, xcd = wgid % NXCD, off = wgid / NXCD; wgid = (xcd < r ? xcd * (q + 1) : r * (q + 1) + (xcd - r) * q) + off; }
        const int nig = WGM * nN, gid = wgid / nig, fm = gid * WGM, gsz = (nM - fm) < WGM ? (nM - fm) : WGM;
        u.pm = fm + ((wgid % nig) % gsz); u.pn = (wgid % nig) / gsz; u.g = 0; return true;
    }
};
struct GroupOrder {
    int nM, upg, total, G, c;
    __device__ void init(int nM_, int nN_, int ngroups, int G_, int c_) { nM = nM_; upg = nM_ * nN_; total = upg * ngroups; G = G_; c = c_; }
    __device__ bool next(int i, Unit& u) const {
        const long L = (long)i * G + c; if (L >= total) return false;
        const int l = (int)L; u.g = l / upg; const int w = l % upg; u.pm = w % nM; u.pn = w / nM; return true;
    }
};

__device__ __forceinline__ unsigned cvt_pk_bf16(float lo, float hi) { unsigned r; asm volatile("v_cvt_pk_bf16_f32 %0, %1, %2" : "=v"(r) : "v"(lo), "v"(hi)); return r; }
__device__ __forceinline__ u32x4 pack8(f32x4 a, f32x4 b) { u32x4 w; w.x = cvt_pk_bf16(a[0], a[1]); w.y = cvt_pk_bf16(a[2], a[3]); w.z = cvt_pk_bf16(b[0], b[1]); w.w = cvt_pk_bf16(b[2], b[3]); return w; }
__device__ __forceinline__ void unpack8(u32x4 w, f32x4& a, f32x4& b) {
    a[0] = __uint_as_float(w.x << 16); a[1] = __uint_as_float(w.x & 0xffff0000u); a[2] = __uint_as_float(w.y << 16); a[3] = __uint_as_float(w.y & 0xffff0000u);
    b[0] = __uint_as_float(w.z << 16); b[1] = __uint_as_float(w.z & 0xffff0000u); b[2] = __uint_as_float(w.w << 16); b[3] = __uint_as_float(w.w & 0xffff0000u); }

template <class Epi, class Sched, bool ALIGN_EPI>
__device__ __forceinline__ void gemm_phase(PG8_LAS unsigned char* lds, const Gemm g, const Sched& S, const Epi& E, unsigned long long& pacc, const int pon = 0) {
    int tid_ = threadIdx.x; asm volatile("" : "+v"(tid_));
    const int tid = tid_, wid = __builtin_amdgcn_readfirstlane(tid >> 6), lane = tid & 63, wr = wid >> 2, wc = wid & 3, fr = lane & 15, fq = lane >> 4;
    const int K = g.K, nt = K / BK;
    unsigned voffA[2], voffB[2];
#pragma unroll
    for (int i = 0; i < 2; ++i) { int R, C; stage_rc(tid * 16 + i * 8192, R, C); const int Rb = (R & ~31) + perm32(R & 31);
        voffA[i] = (unsigned)(R * g.lda + C) * 2u; voffB[i] = (unsigned)(Rb * g.ldb + C) * 2u; }
    const size_t kstep = (size_t)(BK * 2);
    const size_t hsA = (size_t)HALF * g.lda * 2, hsB = (size_t)HALF * g.ldb * 2;
    const size_t tsA = 2 * hsA, tsB = 2 * hsB;
    const unsigned ldsw = (unsigned)wid * 1024u;
    const int aoff = lds_byte(wr * 64 + fr, fq * 8), boff = lds_byte(wc * 32 + fr, fq * 8);
#define PG8_SA(b, h) (((b) * 2 + (h)) * HTB)
#define PG8_SB(b, h) ((4 + (b) * 2 + (h)) * HTB)
#define PG8_STAGE(bufoff, gbase, voff) do { _Pragma("unroll") for (int _i = 0; _i < 2; ++_i) \
        __builtin_amdgcn_global_load_lds((const unsigned*)((const char*)(gbase) + (voff)[_i]), (PG8_LAS unsigned*)(lds + (bufoff) + ldsw + _i * 8192), 16, 0, 0); } while (0)
#define PG8_LDA(dst, b, h) do { _Pragma("unroll") for (int m = 0; m < 4; ++m) _Pragma("unroll") for (int k = 0; k < 2; ++k) dst[m][k] = *(const PG8_LAS bf16x8*)(lds + PG8_SA(b, h) + aoff + m * 2048 + k * 1024); } while (0)
#define PG8_LDB(dst, b, h) do { _Pragma("unroll") for (int n = 0; n < 2; ++n) _Pragma("unroll") for (int k = 0; k < 2; ++k) dst[n][k] = *(const PG8_LAS bf16x8*)(lds + PG8_SB(b, h) + boff + n * 2048 + k * 1024); } while (0)
#define PG8_MMA(ai, bj, At, Bt) do { __builtin_amdgcn_s_setprio(1); _Pragma("unroll") for (int m = 0; m < 4; ++m) _Pragma("unroll") for (int n = 0; n < 2; ++n) _Pragma("unroll") for (int k = 0; k < 2; ++k) \
        acc[ai][bj][m][n] = __builtin_amdgcn_mfma_f32_16x16x32_bf16(Bt[n][k], At[m][k], acc[ai][bj][m][n], 0, 0, 0); __builtin_amdgcn_s_setprio(0); } while (0)
#define PG8_WAIT_V(n) asm volatile("s_waitcnt vmcnt(" #n ")" ::: "memory")
#define PG8_WAIT_L(n) asm volatile("s_waitcnt lgkmcnt(" #n ")" ::: "memory")
#define PG8_BAR __builtin_amdgcn_s_barrier()
#define PG8_SCHED __builtin_amdgcn_sched_barrier(0)
    Unit cur, nxt; int ui = 0;
    if (!S.next(0, cur)) return;
    f32x4 acc[2][2][4][2];
#pragma unroll
    for (int a = 0; a < 2; ++a)
#pragma unroll
        for (int b = 0; b < 2; ++b)
#pragma unroll
            for (int m = 0; m < 4; ++m)
#pragma unroll
                for (int n = 0; n < 2; ++n) acc[a][b][m][n] = (f32x4){0.f, 0.f, 0.f, 0.f};
    bf16x8 At[4][2], B0[2][2], B1[2][2];
    const char* cA = (const char*)g.A + (size_t)cur.g * g.gsA + (size_t)cur.pm * tsA; const char* cB = (const char*)g.Bt + (size_t)cur.g * g.gsB + (size_t)cur.pn * tsB;
    { const float pf0 = E.prefetch(cur, tid); *(PG8_LAS float*)(lds + STAGE_BYTES + tid * 4) = pf0; }
    PG8_STAGE(PG8_SB(0, 0), cB, voffB); PG8_STAGE(PG8_SB(0, 1), cB + hsB, voffB); PG8_STAGE(PG8_SA(0, 0), cA, voffA); PG8_STAGE(PG8_SA(0, 1), cA + hsA, voffA);
    if (wr == 1) PG8_BAR;
    PG8_WAIT_V(2); PG8_BAR;
    PG8_STAGE(PG8_SB(1, 0), cB + kstep, voffB); PG8_STAGE(PG8_SA(1, 0), cA + kstep, voffA); PG8_STAGE(PG8_SB(1, 1), cB + hsB + kstep, voffB);
    PG8_WAIT_V(6); PG8_BAR;
    for (;;) {
        const bool has_next = S.next(ui + 1, nxt);
        const char* nA = has_next ? (const char*)g.A + (size_t)nxt.g * g.gsA + (size_t)nxt.pm * tsA : cA; const char* nB = has_next ? (const char*)g.Bt + (size_t)nxt.g * g.gsB + (size_t)nxt.pn * tsB : cB;
        for (int t = 0; t < nt; t += 2) {
            const bool last = (t == nt - 2);
            const char* a1 = cA + (size_t)(t + 1) * kstep;
            const char* a2 = last ? nA : cA + (size_t)(t + 2) * kstep; const char* b2 = last ? nB : cB + (size_t)(t + 2) * kstep;
            const char* a3 = a2 + kstep; const char* b3 = b2 + kstep;
            PG8_LDB(B0, 0, 0); PG8_LDB(B1, 0, 1); PG8_SCHED; PG8_LDA(At, 0, 0); PG8_STAGE(PG8_SA(1, 1), a1 + hsA, voffA);
            PG8_WAIT_V(8); PG8_WAIT_L(0); PG8_BAR; PG8_MMA(0, 0, At, B0); PG8_MMA(0, 1, At, B1); PG8_BAR; PG8_SCHED;
            PG8_LDA(At, 0, 1); PG8_STAGE(PG8_SB(0, 0), b2, voffB); PG8_STAGE(PG8_SB(0, 1), b2 + hsB, voffB); PG8_STAGE(PG8_SA(0, 0), a2, voffA);
            PG8_WAIT_V(8); PG8_WAIT_L(0); PG8_BAR; PG8_MMA(1, 0, At, B0); PG8_MMA(1, 1, At, B1); PG8_BAR; PG8_SCHED;
            PG8_LDB(B0, 1, 0); PG8_LDB(B1, 1, 1); PG8_SCHED; PG8_LDA(At, 1, 0); PG8_STAGE(PG8_SA(0, 1), a2 + hsA, voffA);
            PG8_WAIT_V(8); PG8_WAIT_L(0); PG8_BAR; PG8_MMA(0, 0, At, B0); PG8_MMA(0, 1, At, B1); PG8_BAR; PG8_SCHED;
            PG8_LDA(At, 1, 1); PG8_STAGE(PG8_SB(1, 0), b3, voffB); PG8_STAGE(PG8_SB(1, 1), b3 + hsB, voffB); PG8_STAGE(PG8_SA(1, 0), a3, voffA);
            PG8_WAIT_V(8); PG8_WAIT_L(0); PG8_BAR; PG8_MMA(1, 0, At, B0); PG8_MMA(1, 1, At, B1); PG8_BAR; PG8_SCHED;
        }
        if constexpr (ALIGN_EPI) { if (wr == 0) PG8_BAR; }
        unsigned long long pt0 = 0; if (pon) pt0 = __builtin_amdgcn_s_memrealtime();
        const float pfn = has_next ? E.prefetch(nxt, tid) : 0.f;
        E(acc, cur, wr, wc, fr, fq, (const PG8_LAS float*)(lds + STAGE_BYTES + (ui & 1) * 2048));
        *(PG8_LAS float*)(lds + STAGE_BYTES + ((ui + 1) & 1) * 2048 + tid * 4) = pfn;
        if (pon) { if (pon == 2) asm volatile("s_waitcnt vmcnt(0)" ::: "memory"); pacc += __builtin_amdgcn_s_memrealtime() - pt0; }
        if (!has_next) break;
#pragma unroll
        for (int a = 0; a < 2; ++a)
#pragma unroll
            for (int b = 0; b < 2; ++b)
#pragma unroll
                for (int m = 0; m < 4; ++m)
#pragma unroll
                    for (int n = 0; n < 2; ++n) acc[a][b][m][n] = (f32x4){0.f, 0.f, 0.f, 0.f};
        cur = nxt; cA = nA; cB = nB; ++ui;
        if constexpr (ALIGN_EPI) { if (wr == 1) PG8_BAR; }
    }
    PG8_WAIT_V(0);
    if constexpr (!ALIGN_EPI) { if (wr == 0) PG8_BAR; }
    PG8_BAR;
#undef PG8_SA
#undef PG8_SB
#undef PG8_STAGE
#undef PG8_LDA
#undef PG8_LDB
#undef PG8_MMA
#undef PG8_WAIT_V
#undef PG8_WAIT_L
#undef PG8_BAR
#undef PG8_SCHED
}
}

using pg8::f32x4; using pg8::u32x4; using pg8::u32x2; using pg8::bf16x8; using pg8::pack8; using pg8::unpack8; using pg8::cvt_pk_bf16;
typedef unsigned short bf16;
#define LAS __attribute__((address_space(3)))

constexpr int NB = 8, SEQ = 4096, D = 1024, FF = 4096, M = NB * SEQ;
constexpr int TCH = 32, NCH = SEQ / TCH;
constexpr int UK = TCH * 16 + 128;
constexpr float EPS = 1e-6f;

constexpr size_t MiB = 1u << 20;
constexpr size_t WS_MOD = 1 * MiB, WS_SHW = 2 * MiB, WS_ABT = 3 * MiB, WS_PART = 4 * MiB, WS_PARTV = 6 * MiB;
constexpr size_t WS_W1 = 8 * MiB, WS_W2 = 40 * MiB, WS_WCI = 72 * MiB, WS_WCO = 84 * MiB, WS_WSI = 88 * MiB, WS_WGLU = 90 * MiB, WS_WSO = 92 * MiB, WS_WGI = 94 * MiB, WS_WGO = 98 * MiB, WS_WST = 100 * MiB;
constexpr size_t WS_TOEP = 101 * MiB, WS_MST = 141 * MiB;
constexpr size_t WS_XB = 160 * MiB, WS_HID = 224 * MiB, WS_T0 = 224 * MiB, WS_T1 = 288 * MiB, WS_T2 = 352 * MiB, WS_T3 = 416 * MiB;
constexpr size_t WS_UEXT = WS_T0, WS_SEND = 304 * MiB, WS_END = 480 * MiB;
constexpr int LDS_BYTES = 147456;

struct Params { const float* in[30]; float* out; unsigned char* ws; };
#ifndef PROBE_ID
#define PROBE_ID 0
#endif
#define PROBE_K 4
#define PB(id) do { if (PROBE_ID == (id)) pr_t0 = __builtin_amdgcn_s_memrealtime(); } while (0)
#define PE(id) do { if (PROBE_ID == (id)) pr_acc += __builtin_amdgcn_s_memrealtime() - pr_t0; } while (0)

__device__ __forceinline__ float wave_sum(float v) {
#pragma unroll
    for (int o = 1; o < 64; o <<= 1) v += __shfl_xor(v, o);
    return v;
}
__device__ __forceinline__ float sum4(f32x4 a) { return (a[0] + a[1]) + (a[2] + a[3]); }
__device__ __forceinline__ float dot4(f32x4 a) { return (a[0] * a[0] + a[1] * a[1]) + (a[2] * a[2] + a[3] * a[3]); }
typedef unsigned long long u64;
constexpr float SS_SCALE = 1048576.0f;
__device__ __forceinline__ float rstd_from(u64 v) { return rsqrtf((float)v * (1.0f / (SS_SCALE * 1024.0f)) + EPS); }
__device__ __forceinline__ void ss_add(u64* p, float ss) { (void)__hip_atomic_fetch_add(p, (u64)(ss * SS_SCALE), __ATOMIC_RELAXED, __HIP_MEMORY_SCOPE_AGENT); }
__device__ __forceinline__ float sigmoid_f(float x) { return __builtin_amdgcn_rcpf(1.0f + __builtin_amdgcn_exp2f(-1.4426950408889634f * x)); }
__device__ __forceinline__ float gelu_tanh_f(float y) { const float t = 0.7978845608028654f * (y + 0.044715f * y * y * y); return y * sigmoid_f(2.0f * t); }


#define XB_TMO      128
#define XB_XCNT(j)  (256  + 64 * (j))
#define XB_XSUB(j)  (1280 + 64 * (j))
#define XB_XGEN(j)  (2304 + 64 * (j))
#define XB_TOP      3328
#define XB_TOPGEN   3392
#define XCD_BAR_WORDS 3456
#define XB_SPIN_CAP (1u << 18)
__device__ __forceinline__ unsigned xb_ld(unsigned* p)              { return __hip_atomic_load(p, __ATOMIC_RELAXED, __HIP_MEMORY_SCOPE_AGENT); }
__device__ __forceinline__ unsigned xb_add(unsigned* p, unsigned v) { return __hip_atomic_fetch_add(p, v, __ATOMIC_RELAXED, __HIP_MEMORY_SCOPE_AGENT); }
__device__ __forceinline__ unsigned xb_xcc_id() { return (unsigned)__builtin_amdgcn_s_getreg((3 << 11) | 20) & 0xFu; }
#define XB_SPIN(cond, bar) do { unsigned _sp = 0; while (cond) { __builtin_amdgcn_s_sleep(1); \
    if ((++_sp & 255u) == 0u) { if (xb_ld(&(bar)[XB_TMO])) break; if (_sp > XB_SPIN_CAP) { atomicAdd(&(bar)[XB_TMO], 1u); break; } } } } while (0)
struct XcdBarrier { unsigned* bar; unsigned x; volatile LAS unsigned* st; };
__device__ __forceinline__ XcdBarrier xcd_barrier_post(unsigned* bar, volatile LAS unsigned* st) {
    XcdBarrier b; b.bar = bar; b.x = (unsigned)__builtin_amdgcn_readfirstlane((int)xb_xcc_id()); b.st = st;
    if (threadIdx.x == 0) (void)xb_add(&bar[XB_XCNT(b.x)], 1u);
    return b;
}
__device__ __forceinline__ void xcd_barrier_complete(unsigned* bar, unsigned x, unsigned& nloc, unsigned& nx) {
    const unsigned G = gridDim.x * gridDim.y * gridDim.z;
    unsigned sum, cnt, mine, sp = 0u;
    for (;;) {
        sum = 0u; cnt = 0u; mine = 0u;
#pragma unroll
        for (unsigned j = 0; j < 16; ++j) { const unsigned c = xb_ld(&bar[XB_XCNT(j)]); sum += c; cnt += (c > 0u) ? 1u : 0u; mine = (j == x) ? c : mine; }
        if (sum == G) break;
        __builtin_amdgcn_s_sleep(1);
        if ((++sp & 255u) == 0u) { if (xb_ld(&bar[XB_TMO])) break; if (sp > XB_SPIN_CAP) { atomicAdd(&bar[XB_TMO], 1u); break; } }
    }
    nloc = mine > 0u ? mine : 1u; nx = cnt > 0u ? cnt : 1u;
}
__device__ __forceinline__ void xcd_barrier(const XcdBarrier& b) {
    asm volatile("s_waitcnt vmcnt(0)" ::: "memory");
    __syncthreads();
    if (threadIdx.x == 0) {
        unsigned* bar = b.bar; asm volatile("" : "+s"(bar));
        __builtin_amdgcn_s_waitcnt(0);
        unsigned nloc = b.st[0], nx = b.st[1];
        if (nloc == 0u) { xcd_barrier_complete(bar, b.x, nloc, nx); b.st[0] = nloc; b.st[1] = nx; }
        const unsigned old = xb_add(&bar[XB_XSUB(b.x)], 1u);
        const unsigned gen = old / nloc;
        if (old + 1u == (gen + 1u) * nloc) {
            __builtin_amdgcn_fence(__ATOMIC_RELEASE, "agent");
            asm volatile("s_waitcnt vmcnt(0)" ::: "memory");
            const unsigned og = xb_add(&bar[XB_TOP], 1u);
            const unsigned tg = og / nx;
            if (og + 1u == (tg + 1u) * nx) xb_add(&bar[XB_TOPGEN], 1u);
            else XB_SPIN(xb_ld(&bar[XB_TOPGEN]) == tg, bar);
            __builtin_amdgcn_fence(__ATOMIC_ACQUIRE, "agent");
            xb_add(&bar[XB_XGEN(b.x)], 1u);
            asm volatile("s_waitcnt vmcnt(0)" ::: "memory");
        } else {
            XB_SPIN(xb_ld(&bar[XB_XGEN(b.x)]) == gen, bar);
            __builtin_amdgcn_fence(__ATOMIC_ACQUIRE, "agent");
            asm volatile("s_waitcnt vmcnt(0)" ::: "memory");
        }
    }
    __syncthreads();
}

template <int MODE  > struct EpiIn {
    const u64* part; const float* shw; int N; bf16* O0; bf16* O1; u64* partv;
    __device__ __forceinline__ float prefetch(const pg8::Unit& u, int tid) const {
        return tid < 256 ? rstd_from(part[u.pm * 256 + tid]) : shw[(size_t)(u.pm >> 4) * N + u.pn * 256 + (tid - 256)]; }
    __device__ __forceinline__ void operator()(const f32x4 (&acc)[2][2][4][2], const pg8::Unit& u, int wr, int wc, int fr, int fq, const LAS float* pf) const {
        const int row0 = u.pm * 256 + wr * 64 + fr, colt = u.pn * 256 + wc * 32 + 8 * fq;
        f32x4 bv[2][2]; float rsv[2][4];
#pragma unroll
        for (int ai = 0; ai < 2; ++ai)
#pragma unroll
            for (int m = 0; m < 4; ++m) rsv[ai][m] = pf[wr * 64 + fr + ai * 128 + m * 16];
#pragma unroll
        for (int bj = 0; bj < 2; ++bj)
#pragma unroll
            for (int n = 0; n < 2; ++n) bv[bj][n] = *(const LAS f32x4*)(pf + 256 + wc * 32 + 8 * fq + bj * 128 + 4 * n);
#pragma unroll
        for (int ai = 0; ai < 2; ++ai)
#pragma unroll
            for (int m = 0; m < 4; ++m) {
                const int row = row0 + ai * 128 + m * 16; const float rs = rsv[ai][m];
                f32x4 v[2][2];
#pragma unroll
                for (int bj = 0; bj < 2; ++bj)
#pragma unroll
                    for (int n = 0; n < 2; ++n) v[bj][n] = acc[ai][bj][m][n] * rs + bv[bj][n];
                if (MODE == 0) {
                    if (u.pn < 4) {
#pragma unroll
                        for (int bj = 0; bj < 2; ++bj) *(u32x4*)(O0 + (size_t)row * D + colt + bj * 128) = pack8(v[bj][0], v[bj][1]);
                    } else {
                        *(u32x4*)(O1 + (size_t)row * D + (u.pn - 4) * 128 + wc * 32 + 8 * fq) = pack8(v[0][0] * v[1][0], v[0][1] * v[1][1]);
                    }
                } else if (MODE == 1) {
                    const int bb = row >> 12, l = row & 4095;
#pragma unroll
                    for (int bj = 0; bj < 2; ++bj) { const int col = colt + bj * 128, gg = col >> 4, h0 = col & 15;
                        *(u32x4*)(O0 + ((size_t)gg * 1024 + bb * NCH + (l >> 5)) * UK + (l & 31) * 16 + h0) = pack8(v[bj][0], v[bj][1]); }
                } else if (MODE == 2) {
                    if (u.pn < 4) {
#pragma unroll
                        for (int bj = 0; bj < 2; ++bj) *(u32x4*)(O0 + (size_t)row * D + colt + bj * 128) = pack8(v[bj][0], v[bj][1]);
                    } else {
                        float ss = (dot4(v[0][0]) + dot4(v[0][1])) + (dot4(v[1][0]) + dot4(v[1][1]));
#pragma unroll
                        for (int bj = 0; bj < 2; ++bj) *(u32x4*)(O1 + (size_t)row * D + (colt - 1024) + bj * 128) = pack8(v[bj][0], v[bj][1]);
                        ss += __shfl_xor(ss, 16); ss += __shfl_xor(ss, 32);
                        if (fq == 0) ss_add(partv + row, ss);
                    }
                } else {
#pragma unroll
                    for (int bj = 0; bj < 2; ++bj) {
                        f32x4 r0 = __builtin_elementwise_max(v[bj][0], (f32x4){0.f, 0.f, 0.f, 0.f}), r1 = __builtin_elementwise_max(v[bj][1], (f32x4){0.f, 0.f, 0.f, 0.f});
                        *(u32x4*)(O0 + (size_t)row * FF + colt + bj * 128) = pack8(r0 * r0, r1 * r1); }
                }
            }
    }
};
struct EpiRes {
    const bf16* xin; bf16* xout; const float* gate; const float* anext; bf16* xa; u64* padd; u64* pzero;
    __device__ __forceinline__ float prefetch(const pg8::Unit& u, int tid) const {
        const int o = (u.pm >> 4) * D + u.pn * 256 + (tid & 255);
        return tid < 256 ? gate[o] : (anext ? anext[o] : 0.f); }
    __device__ __forceinline__ void operator()(const f32x4 (&acc)[2][2][4][2], const pg8::Unit& u, int wr, int wc, int fr, int fq, const LAS float* pf) const {
        const int row0 = u.pm * 256 + wr * 64 + fr, colt = u.pn * 256 + wc * 32 + 8 * fq;
        f32x4 gv[2][2], av[2][2];
#pragma unroll
        for (int bj = 0; bj < 2; ++bj)
#pragma unroll
            for (int n = 0; n < 2; ++n) { gv[bj][n] = *(const LAS f32x4*)(pf + wc * 32 + 8 * fq + bj * 128 + 4 * n);
                av[bj][n] = *(const LAS f32x4*)(pf + 256 + wc * 32 + 8 * fq + bj * 128 + 4 * n); }
#pragma unroll
        for (int ai = 0; ai < 2; ++ai) {
            u32x4 xr[4][2];
#pragma unroll
            for (int m = 0; m < 4; ++m)
#pragma unroll
                for (int bj = 0; bj < 2; ++bj) xr[m][bj] = *(const u32x4*)(xin + (size_t)(row0 + ai * 128 + m * 16) * D + colt + bj * 128);
#pragma unroll
            for (int m = 0; m < 4; ++m) { const int row = row0 + ai * 128 + m * 16; float ss = 0.f;
#pragma unroll
                for (int bj = 0; bj < 2; ++bj) { const size_t off = (size_t)row * D + colt + bj * 128;
                    f32x4 x0, x1; unpack8(xr[m][bj], x0, x1);
                    x0 = x0 + gv[bj][0] * acc[ai][bj][m][0]; x1 = x1 + gv[bj][1] * acc[ai][bj][m][1];
                    *(u32x4*)(xout + off) = pack8(x0, x1);
                    ss += dot4(x0) + dot4(x1);
                    if (anext) *(u32x4*)(xa + off) = pack8(x0 * av[bj][0], x1 * av[bj][1]); }
                ss += __shfl_xor(ss, 16); ss += __shfl_xor(ss, 32);
                if (fq == 0) { ss_add(padd + row, ss); if (u.pn == 0 && wc == 0) pzero[row] = 0ull; } }
        }
    }
};
struct EpiS1 {
    float* send;
    __device__ __forceinline__ float prefetch(const pg8::Unit&, int) const { return 0.f; }
    __device__ __forceinline__ void operator()(const f32x4 (&acc)[2][2][4][2], const pg8::Unit& u, int wr, int wc, int fr, int fq, const LAS float*) const {
        const int row0 = u.pm * 256 + wr * 64 + fr;
#pragma unroll
        for (int ai = 0; ai < 2; ++ai)
#pragma unroll
            for (int m = 0; m < 4; ++m) { float* p = send + ((size_t)u.g * 1024 + row0 + ai * 128 + m * 16) * 128 + wc * 32 + 8 * fq;
                *(f32x4*)p = acc[ai][0][m][0]; *(f32x4*)(p + 4) = acc[ai][0][m][1]; }
    }
};
struct EpiS3 {
    const bf16* uext; const float* dskip; bf16* Y;
    __device__ __forceinline__ float prefetch(const pg8::Unit&, int) const { return 0.f; }
    __device__ __forceinline__ void operator()(const f32x4 (&acc)[2][2][4][2], const pg8::Unit& u, int wr, int wc, int fr, int fq, const LAS float*) const {
        const int row0 = u.pm * 256 + wr * 64 + fr, colt = u.pn * 256 + wc * 32 + 8 * fq, h0 = colt & 15;
        const f32x4 d0 = *(const f32x4*)(dskip + u.g * 16 + h0), d1 = *(const f32x4*)(dskip + u.g * 16 + h0 + 4);
#pragma unroll
        for (int ai = 0; ai < 2; ++ai) {
            u32x4 ur[4][2];
#pragma unroll
            for (int m = 0; m < 4; ++m)
#pragma unroll
                for (int bj = 0; bj < 2; ++bj) ur[m][bj] = *(const u32x4*)(uext + ((size_t)u.g * 1024 + row0 + ai * 128 + m * 16) * UK + colt + bj * 128);
#pragma unroll
            for (int m = 0; m < 4; ++m) { const int row = row0 + ai * 128 + m * 16;
#pragma unroll
                for (int bj = 0; bj < 2; ++bj) { const int col = colt + bj * 128, t = col >> 4;
                    f32x4 u0, u1; unpack8(ur[m][bj], u0, u1);
                    f32x4 y0 = acc[ai][bj][m][0] + d0 * u0, y1 = acc[ai][bj][m][1] + d1 * u1;
#pragma unroll
                    for (int e = 0; e < 4; ++e) { y0[e] = gelu_tanh_f(y0[e]); y1[e] = gelu_tanh_f(y1[e]); }
                    *(u32x4*)(Y + ((size_t)row * TCH + t) * D + u.g * 16 + h0) = pack8(y0, y1); } } }
    }
};
struct EpiGlu {
    const bf16* Y; const float* gb; bf16* Y2;
    __device__ __forceinline__ float prefetch(const pg8::Unit& u, int tid) const { return gb[u.pn * 256 + (tid & 255)]; }
    __device__ __forceinline__ void operator()(const f32x4 (&acc)[2][2][4][2], const pg8::Unit& u, int wr, int wc, int fr, int fq, const LAS float* pf) const {
        const int row0 = u.pm * 256 + wr * 64 + fr, colt = u.pn * 256 + wc * 32 + 8 * fq;
        f32x4 bv[2][2];
#pragma unroll
        for (int bj = 0; bj < 2; ++bj)
#pragma unroll
            for (int n = 0; n < 2; ++n) bv[bj][n] = *(const LAS f32x4*)(pf + wc * 32 + 8 * fq + bj * 128 + 4 * n);
#pragma unroll
        for (int ai = 0; ai < 2; ++ai) {
            u32x4 yr[4][2];
#pragma unroll
            for (int m = 0; m < 4; ++m)
#pragma unroll
                for (int bj = 0; bj < 2; ++bj) yr[m][bj] = *(const u32x4*)(Y + (size_t)(row0 + ai * 128 + m * 16) * D + colt + bj * 128);
#pragma unroll
            for (int m = 0; m < 4; ++m) { const int row = row0 + ai * 128 + m * 16;
#pragma unroll
                for (int bj = 0; bj < 2; ++bj) { const size_t off = (size_t)row * D + colt + bj * 128;
                    f32x4 y0, y1; unpack8(yr[m][bj], y0, y1);
                    f32x4 z0 = acc[ai][bj][m][0] + bv[bj][0], z1 = acc[ai][bj][m][1] + bv[bj][1];
#pragma unroll
                    for (int e = 0; e < 4; ++e) { y0[e] *= sigmoid_f(z0[e]); y1[e] *= sigmoid_f(z1[e]); }
                    *(u32x4*)(Y2 + off) = pack8(y0, y1); } } }
    }
};

__device__ __forceinline__ void transpose_item(const float* W, int K, int N, bf16* WT, int mode, LAS float* scr, int item, int lane) {
    const int nblk = N / 64, kb = item / nblk, nb = item % nblk, k0 = 64 * kb, n0 = 64 * nb;
    int drow = n0;
    if (mode == 1 && n0 >= 1024) { int nn = n0 - 1024; const int half = nn >> 10; nn &= 1023; drow = 1024 + 256 * (nn >> 7) + 128 * half + (nn & 127); }
    const int kr = lane >> 4, nc = (lane & 15) * 4;
    f32x4 v[16];
#pragma unroll
    for (int i = 0; i < 16; ++i) v[i] = *(const f32x4*)(W + (size_t)(k0 + 4 * i + kr) * N + n0 + nc);
#pragma unroll
    for (int i = 0; i < 16; ++i) { LAS float* d = scr + (4 * i + kr) * 65 + nc; d[0] = v[i][0]; d[1] = v[i][1]; d[2] = v[i][2]; d[3] = v[i][3]; }
    asm volatile("s_waitcnt lgkmcnt(0)" ::: "memory");
    const int c = lane & 7;
#pragma unroll
    for (int j = 0; j < 8; ++j) { const int n = (lane >> 3) + 8 * j; const LAS float* sp = scr + (8 * c) * 65 + n;
        u32x4 o; o.x = cvt_pk_bf16(sp[0 * 65], sp[1 * 65]); o.y = cvt_pk_bf16(sp[2 * 65], sp[3 * 65]); o.z = cvt_pk_bf16(sp[4 * 65], sp[5 * 65]); o.w = cvt_pk_bf16(sp[6 * 65], sp[7 * 65]);
        *(u32x4*)(WT + (size_t)(drow + n) * K + k0 + 8 * c) = o; }
    asm volatile("s_waitcnt lgkmcnt(0)" ::: "memory");
}

__global__ void __launch_bounds__(512, 2) mk_fwd(Params P) {
    extern __shared__ __attribute__((aligned(16))) unsigned char lds_raw[];
    cg::grid_group grid = cg::this_grid();
    LAS unsigned char* lds = (LAS unsigned char*)lds_raw;
    const int G = gridDim.x;
    const int NGW = G * 8;
#define FRESH_TID() int bid = blockIdx.x; asm volatile("" : "+s"(bid)); const int vcu = (G % 8 == 0) ? (bid % 8) * (G / 8) + bid / 8 : bid; (void)vcu; int tid = threadIdx.x; asm volatile("" : "+v"(tid)); const int lane = tid & 63, wave = __builtin_amdgcn_readfirstlane(tid >> 6); const int gw = bid * 8 + wave; (void)lane; (void)gw
    unsigned char* ws = P.ws;
    float* modv = (float*)(ws + WS_MOD); float* shw = (float*)(ws + WS_SHW); float* abt = (float*)(ws + WS_ABT);
    u64* partA = (u64*)(ws + WS_PART); u64* partB = (u64*)(ws + WS_PART + 512 * 1024); u64* partv = (u64*)(ws + WS_PARTV);
    bf16* W1t = (bf16*)(ws + WS_W1); bf16* W2t = (bf16*)(ws + WS_W2); bf16* Wci = (bf16*)(ws + WS_WCI); bf16* Wco = (bf16*)(ws + WS_WCO);
    bf16* Wsi = (bf16*)(ws + WS_WSI); bf16* Wglu = (bf16*)(ws + WS_WGLU); bf16* Wso = (bf16*)(ws + WS_WSO); bf16* Wgi = (bf16*)(ws + WS_WGI); bf16* Wgo = (bf16*)(ws + WS_WGO);
    bf16* WSt = (bf16*)(ws + WS_WST); bf16* Toep = (bf16*)(ws + WS_TOEP); bf16* Mst = (bf16*)(ws + WS_MST);
    bf16* XB = (bf16*)(ws + WS_XB); bf16* XA = (bf16*)P.out;     bf16* HID = (bf16*)(ws + WS_HID); bf16* T0 = (bf16*)(ws + WS_T0); bf16* T1 = (bf16*)(ws + WS_T1); bf16* T2 = (bf16*)(ws + WS_T2); bf16* T3 = (bf16*)(ws + WS_T3);
    bf16* UEXT = (bf16*)(ws + WS_UEXT); float* SEND = (float*)(ws + WS_SEND);
    unsigned long long pr_acc = 0, pr_t0 = 0; (void)pr_acc; (void)pr_t0;
    volatile LAS unsigned* misc = (volatile LAS unsigned*)(lds + LDS_BYTES - 64);
    if (threadIdx.x < 2) misc[threadIdx.x] = 0u;
    __syncthreads();
    const XcdBarrier xbar = xcd_barrier_post((unsigned*)ws, misc);
#define GRID_BAR() do { if (PROBE_ID == 14) pr_t0 = __builtin_amdgcn_s_memrealtime(); xcd_barrier(xbar); if (PROBE_ID == 14) pr_acc += __builtin_amdgcn_s_memrealtime() - pr_t0; } while (0)
    PB(1);

    {
    FRESH_TID();
    for (int it = bid; it < 192; it += G) {
        LAS float* cs = (LAS float*)lds; LAS float* red = cs + 8192;
        const float* c = P.in[1];
        for (int e = tid; e < 8192; e += 512) { const float v = c[e]; cs[e] = v / (1.0f + __expf(-v)); }
        __syncthreads();
        const int i = it / 48, n0 = (it % 48) * 128;
        typedef float f32x2 __attribute__((ext_vector_type(2)));
        const float* W = P.in[2] + (size_t)i * 1024 * 6144 + n0 + 2 * lane;
        f32x2 acc[8];
#pragma unroll
        for (int b = 0; b < 8; ++b) acc[b] = (f32x2){0.f, 0.f};
        const int k0 = wave * 128;
        for (int kk = 0; kk < 128; kk += 32) { f32x2 w[32];
#pragma unroll
            for (int k = 0; k < 32; ++k) w[k] = *(const f32x2*)(W + (size_t)(k0 + kk + k) * 6144);
#pragma unroll
            for (int k = 0; k < 32; ++k)
#pragma unroll
                for (int b = 0; b < 8; ++b) acc[b] += cs[b * 1024 + k0 + kk + k] * w[k]; }
#pragma unroll
        for (int b = 0; b < 8; ++b) *(LAS f32x2*)(red + (wave * 8 + b) * 128 + 2 * lane) = acc[b];
        __syncthreads();
#pragma unroll
        for (int j = 0; j < 2; ++j) { const int o = tid + 512 * j, b = o >> 7, nn = o & 127, n = n0 + nn, kind = n >> 10, col = n & 1023;
            float sacc = P.in[3][i * 6144 + n];
#pragma unroll
            for (int w = 0; w < 8; ++w) sacc += red[(w * 8 + b) * 128 + nn];
            if (kind == 1) sacc = (1.0f + sacc) * P.in[4][i * 1024 + col];
            if (kind == 4) sacc = (1.0f + sacc) * P.in[5][i * 1024 + col];
            const int slot = kind == 0 ? 1 : kind == 1 ? 0 : kind == 2 ? 2 : kind == 3 ? 4 : kind == 4 ? 3 : 5;
            modv[((i * 6 + slot) * 8 + b) * 1024 + col] = sacc; }
        __syncthreads();
    }
    for (int it = bid; it < 256; it += G) {
        const int g = it >> 2, q = it & 3;
        LAS float* pw_re = (LAS float*)lds; LAS float* pw_im = pw_re + 2148; LAS float* bb_re = pw_im + 2148; LAS float* bb_im = bb_re + 1024;
        LAS float* cc_re = bb_im + 1024; LAS float* cc_im = cc_re + 16 * 65; LAS float* Kd = cc_im + 16 * 65;
        __syncthreads();
        if (tid < 64) { const int p = tid;
            const float dt = expf(P.in[16][g]); const float are = P.in[14][g * 64 + p], aim = P.in[15][g * 64 + p];
            const float mag = expf(are * dt); float sn, cs_; sincosf(aim * dt, &sn, &cs_);
            const float abr = mag * cs_, abi = mag * sn, den = are * are + aim * aim, nr = abr - 1.0f, ni = abi;
            const float fre = (nr * are + ni * aim) / den, fim = (ni * are - nr * aim) / den;
            float pr = 1.0f, pi = 0.0f;
            for (int d = 0; d <= 32; ++d) { pw_re[d * 65 + p] = pr; pw_im[d * 65 + p] = pi; const float npr = pr * abr - pi * abi, npi = pr * abi + pi * abr; pr = npr; pi = npi; }
            for (int h = 0; h < 16; ++h) { const float br = P.in[17][(g * 64 + p) * 16 + h], bi = P.in[18][(g * 64 + p) * 16 + h]; bb_re[p * 16 + h] = fre * br - fim * bi; bb_im[p * 16 + h] = fre * bi + fim * br; }
            if (q == 0) { abt[(g * 64 + p) * 2] = pw_re[32 * 65 + p]; abt[(g * 64 + p) * 2 + 1] = pw_im[32 * 65 + p]; }
        }
        for (int e = tid; e < 1024; e += 512) { const int h = e >> 6, p = e & 63; cc_re[h * 65 + p] = P.in[19][g * 1024 + e]; cc_im[h * 65 + p] = P.in[20][g * 1024 + e]; }
        __syncthreads();
        { const int d = tid >> 4, h = tid & 15; f32x4 s4[4];
#pragma unroll
            for (int e = 0; e < 4; ++e) s4[e] = (f32x4){0.f, 0.f, 0.f, 0.f};
#pragma unroll 4
            for (int p = 0; p < 64; ++p) { const float cr = cc_re[h * 65 + p], ci = cc_im[h * 65 + p], pr = pw_re[d * 65 + p], pi = pw_im[d * 65 + p];
                const float wre = cr * pr - ci * pi, wim = cr * pi + ci * pr;
                const LAS f32x4* br4 = (const LAS f32x4*)(bb_re + p * 16); const LAS f32x4* bi4 = (const LAS f32x4*)(bb_im + p * 16);
#pragma unroll
                for (int e = 0; e < 4; ++e) s4[e] += wre * br4[e] - wim * bi4[e]; }
#pragma unroll
            for (int e = 0; e < 4; ++e) *(LAS f32x4*)(Kd + (d * 16 + h) * 16 + 4 * e) = s4[e]; }
        __syncthreads();
        for (int v = tid; v < 10240; v += 512) { const int rr = v / 80, kv = v % 80, n = 128 * q + rr, t = n >> 4, h = n & 15, k0 = 8 * kv;
            float val[8];
            if (k0 < 512) { const int j = k0 >> 4, h0 = k0 & 15;
#pragma unroll
                for (int e = 0; e < 8; ++e) val[e] = (j <= t) ? Kd[((t - j) * 16 + h) * 16 + h0 + e] : 0.f;
            } else { const int p0 = (k0 - 512) >> 1;
#pragma unroll
                for (int pp = 0; pp < 4; ++pp) { const int p = p0 + pp; const float cr = cc_re[h * 65 + p], ci = cc_im[h * 65 + p], pr = pw_re[(t + 1) * 65 + p], pi = pw_im[(t + 1) * 65 + p];
                    val[2 * pp] = cr * pr - ci * pi; val[2 * pp + 1] = -(cr * pi + ci * pr); } }
            u32x4 o; o.x = cvt_pk_bf16(val[0], val[1]); o.y = cvt_pk_bf16(val[2], val[3]); o.z = cvt_pk_bf16(val[4], val[5]); o.w = cvt_pk_bf16(val[6], val[7]);
            *(u32x4*)(Toep + ((size_t)g * 512 + n) * UK + k0) = o; }
        for (int v = tid; v < 4096; v += 512) { const int rr = v >> 6, kv = v & 63, n = 64 * q + rr, k0 = 8 * kv, j = k0 >> 4, h0 = k0 & 15;
            float val[8];
            if (n < 128) { const int p = n >> 1, ri = n & 1, d = 31 - j; const float pr = pw_re[d * 65 + p], pi = pw_im[d * 65 + p];
#pragma unroll
                for (int e = 0; e < 8; ++e) { const float br = bb_re[p * 16 + h0 + e], bi = bb_im[p * 16 + h0 + e]; val[e] = ri == 0 ? (pr * br - pi * bi) : (pr * bi + pi * br); }
            } else {
#pragma unroll
                for (int e = 0; e < 8; ++e) val[e] = 0.f; }
            u32x4 o; o.x = cvt_pk_bf16(val[0], val[1]); o.y = cvt_pk_bf16(val[2], val[3]); o.z = cvt_pk_bf16(val[4], val[5]); o.w = cvt_pk_bf16(val[6], val[7]);
            *(u32x4*)(Mst + ((size_t)g * 256 + n) * 512 + k0) = o; }
        __syncthreads();
    }
    for (int e = bid * 512 + tid; e < 8 * 128 * 128; e += G * 512) { const int t = (e >> 7) & 127, s = e & 127; WSt[e] = (s <= t) ? (bf16)(cvt_pk_bf16(P.in[27][e], 0.f) & 0xffffu) : (bf16)0; }
    {
        LAS float* scr = (LAS float*)(lds + wave * 16640);
        __syncthreads();
        for (int it = gw; it < 11776; it += NGW) {
            int r = it;
            if (r < 4096) { const int mt = r >> 10; transpose_item(P.in[6] + (size_t)mt * D * FF, D, FF, W1t + (size_t)mt * D * FF, 0, scr, r & 1023, lane); continue; } r -= 4096;
            if (r < 4096) { const int mt = r >> 10; transpose_item(P.in[7] + (size_t)mt * D * FF, FF, D, W2t + (size_t)mt * D * FF, 0, scr, r & 1023, lane); continue; } r -= 4096;
            if (r < 1536) { const int mt = r / 768; transpose_item(P.in[9] + (size_t)mt * D * 3072, D, 3072, Wci + (size_t)mt * D * 3072, 1, scr, r % 768, lane); continue; } r -= 1536;
            if (r < 512) { const int mt = r >> 8; transpose_item(P.in[12] + (size_t)mt * D * D, D, D, Wco + (size_t)mt * D * D, 0, scr, r & 255, lane); continue; } r -= 512;
            if (r < 256) { transpose_item(P.in[13], D, D, Wsi, 0, scr, r, lane); continue; } r -= 256;
            if (r < 256) { transpose_item(P.in[22], D, D, Wglu, 0, scr, r, lane); continue; } r -= 256;
            if (r < 256) { transpose_item(P.in[24], D, D, Wso, 0, scr, r, lane); continue; } r -= 256;
            if (r < 512) { transpose_item(P.in[25], D, 2048, Wgi, 0, scr, r, lane); continue; } r -= 512;
            transpose_item(P.in[29], D, D, Wgo, 0, scr, r, lane);
        }
    }
    }
    if (P.ws == nullptr) grid.sync();
    GRID_BAR();
    PE(1); PB(2);

    {
    FRESH_TID();
    for (int task = gw; task < 1600; task += NGW) {
        const int r = task * 16;
        int start, N, layer, slot; const bf16* Wt;
        if (r < 3072) { start = 0; N = 3072; Wt = Wci; layer = 0; slot = 1; }
        else if (r < 7168) { start = 3072; N = 4096; Wt = W1t; layer = 0; slot = 4; }
        else if (r < 8192) { start = 7168; N = 1024; Wt = Wsi; layer = 1; slot = 1; }
        else if (r < 12288) { start = 8192; N = 4096; Wt = W1t + (size_t)1 * D * FF; layer = 1; slot = 4; }
        else if (r < 14336) { start = 12288; N = 2048; Wt = Wgi; layer = 2; slot = 1; }
        else if (r < 18432) { start = 14336; N = 4096; Wt = W1t + (size_t)2 * D * FF; layer = 2; slot = 4; }
        else if (r < 21504) { start = 18432; N = 3072; Wt = Wci + (size_t)D * 3072; layer = 3; slot = 1; }
        else { start = 21504; N = 4096; Wt = W1t + (size_t)3 * D * FF; layer = 3; slot = 4; }
        const int n0 = r - start, fr = lane & 15, fq = lane >> 4;
        const float* sh = modv + (size_t)((layer * 6 + slot) * 8) * 1024 + (size_t)(fr & 7) * 1024 + 8 * fq;
        const bf16* wp = Wt + (size_t)(n0 + fr) * D + 8 * fq;
        f32x4 acc = {0.f, 0.f, 0.f, 0.f};
        for (int k0 = 0; k0 < 1024; k0 += 256) { u32x4 wv[8]; f32x4 sa[8], sb[8];
#pragma unroll
            for (int j = 0; j < 8; ++j) { wv[j] = *(const u32x4*)(wp + k0 + 32 * j); sa[j] = *(const f32x4*)(sh + k0 + 32 * j); sb[j] = *(const f32x4*)(sh + k0 + 32 * j + 4); }
#pragma unroll
            for (int j = 0; j < 8; ++j) {
                if (fr >= 8) { sa[j] = (f32x4){0.f, 0.f, 0.f, 0.f}; sb[j] = sa[j]; }
                const u32x4 hi = pack8(sa[j], sb[j]); f32x4 ha, hb; unpack8(hi, ha, hb);
                const u32x4 lo = pack8(sa[j] - ha, sb[j] - hb);
                acc = __builtin_amdgcn_mfma_f32_16x16x32_bf16(__builtin_bit_cast(bf16x8, wv[j]), __builtin_bit_cast(bf16x8, hi), acc, 0, 0, 0);
                acc = __builtin_amdgcn_mfma_f32_16x16x32_bf16(__builtin_bit_cast(bf16x8, wv[j]), __builtin_bit_cast(bf16x8, lo), acc, 0, 0, 0); } }
        if (fr < 8) *(f32x4*)(shw + (size_t)8 * start + (size_t)fr * N + n0 + 4 * fq) = acc;
    }
    for (int m0 = gw * 4; m0 < M; m0 += NGW * 4) {
        const f32x4* ar = (const f32x4*)(modv + (size_t)(m0 >> 12) * 1024) + lane;
        f32x4 v[4][4]; float s[4];
#pragma unroll
        for (int r = 0; r < 4; ++r)
#pragma unroll
            for (int j = 0; j < 4; ++j) v[r][j] = *((const f32x4*)(P.in[0] + (size_t)(m0 + r) * D) + lane + 64 * j);
#pragma unroll
        for (int r = 0; r < 4; ++r) { s[r] = 0.f;
#pragma unroll
            for (int j = 0; j < 4; ++j) s[r] += dot4(v[r][j]); }
#pragma unroll
        for (int o = 1; o < 64; o <<= 1) {
#pragma unroll
            for (int r = 0; r < 4; ++r) s[r] += __shfl_xor(s[r], o); }
#pragma unroll
        for (int r = 0; r < 4; ++r) {
#pragma unroll
            for (int j = 0; j < 4; ++j) { const f32x4 o = v[r][j] * ar[64 * j]; u32x2 w; w.x = cvt_pk_bf16(o[0], o[1]); w.y = cvt_pk_bf16(o[2], o[3]); *((u32x2*)(XA + (size_t)(m0 + r) * D) + lane + 64 * j) = w;
                u32x2 wx; wx.x = cvt_pk_bf16(v[r][j][0], v[r][j][1]); wx.y = cvt_pk_bf16(v[r][j][2], v[r][j][3]); *((u32x2*)(XB + (size_t)(m0 + r) * D) + lane + 64 * j) = wx; }
            if (lane == 0) { partB[m0 + r] = (u64)(s[r] * SS_SCALE); partA[m0 + r] = 0ull; partv[m0 + r] = 0ull; } }
    }
    }
    GRID_BAR();
    PE(2);

#pragma unroll 1
    for (int li = 0; li < 4; ++li) {
        FRESH_TID();
        const int kind = li % 3, jm = li / 3;
        const float* mv = modv + (size_t)li * 6 * 8192;
        const int mstart = li == 0 ? 0 : li == 1 ? 7168 : li == 2 ? 12288 : 18432;
        const int fstart = li == 0 ? 3072 : li == 1 ? 8192 : li == 2 ? 14336 : 21504;
        const bf16* wout_t; const bf16* aout;
        if (kind == 0) {
            PB(6);
            {   pg8::Gemm g{XA, Wci + (size_t)jm * D * 3072, D, D, D, 0, 0}; pg8::StaticOrder S; S.init(M, 3072, G, bid);
                EpiIn<0> E{partB, shw + (size_t)8 * mstart, 3072, T0, T1, nullptr};
                pg8::gemm_phase<EpiIn<0>, pg8::StaticOrder, true>(lds, g, S, E, pr_acc); }
            GRID_BAR();
            PE(6); PB(8);
            {
                const float* cw = P.in[10] + (size_t)jm * 3 * D; const float* cb = P.in[11] + (size_t)jm * D;
                for (int run = bid * 4 + (tid >> 7); run < M / 32; run += G * 4) {
                    const int tok0 = run * 32, col = (tid & 127) * 8;
                    f32x4 c0a = *(const f32x4*)(cw + col), c0b = *(const f32x4*)(cw + col + 4), c1a = *(const f32x4*)(cw + D + col), c1b = *(const f32x4*)(cw + D + col + 4);
                    f32x4 c2a = *(const f32x4*)(cw + 2 * D + col), c2b = *(const f32x4*)(cw + 2 * D + col + 4), cba = *(const f32x4*)(cb + col), cbb = *(const f32x4*)(cb + col + 4);
                    f32x4 z1a = {0.f, 0.f, 0.f, 0.f}, z1b = z1a, z2a = z1a, z2b = z1a;
                    if ((tok0 & (SEQ - 1)) != 0) { unpack8(*(const u32x4*)(T1 + (size_t)(tok0 - 1) * D + col), z1a, z1b); unpack8(*(const u32x4*)(T1 + (size_t)(tok0 - 2) * D + col), z2a, z2b); }
                    for (int t0 = 0; t0 < 32; t0 += 8) { u32x4 zr[8], br[8];
#pragma unroll
                        for (int t = 0; t < 8; ++t) { const size_t off = (size_t)(tok0 + t0 + t) * D + col; zr[t] = *(const u32x4*)(T1 + off); br[t] = *(const u32x4*)(T0 + off); }
#pragma unroll
                        for (int t = 0; t < 8; ++t) { const size_t off = (size_t)(tok0 + t0 + t) * D + col;
                            f32x4 za, zb, ba, bb; unpack8(zr[t], za, zb); unpack8(br[t], ba, bb);
                            const f32x4 oa = ba * (c0a * z2a + c1a * z1a + c2a * za + cba), ob = bb * (c0b * z2b + c1b * z1b + c2b * zb + cbb);
                            *(u32x4*)(T2 + off) = pack8(oa, ob);
                            z2a = z1a; z2b = z1b; z1a = za; z1b = zb; } }
                }
            }
            GRID_BAR();
            PE(8);
            wout_t = Wco + (size_t)jm * D * D; aout = T2;
        } else if (kind == 1) {
            PB(6);
            {   pg8::Gemm g{XA, Wsi, D, D, D, 0, 0}; pg8::StaticOrder S; S.init(M, D, G, bid);
                EpiIn<1> E{partB, shw + (size_t)8 * mstart, D, UEXT, nullptr, nullptr};
                pg8::gemm_phase<EpiIn<1>, pg8::StaticOrder, true>(lds, g, S, E, pr_acc); }
            GRID_BAR();
            PE(6); PB(7);
            {   pg8::Gemm g{UEXT, Mst, 512, UK, 512, (size_t)1024 * UK * 2, (size_t)256 * 512 * 2}; pg8::GroupOrder S; S.init(4, 1, 64, G, vcu);
                EpiS1 E{SEND};
                pg8::gemm_phase<EpiS1, pg8::GroupOrder, true>(lds, g, S, E, pr_acc); }
            GRID_BAR();
            for (int wg = wave * G + bid; wg < 512; wg += 8 * G) { const int b = wg & 7, g = wg >> 3, p = lane;
                const float ar = abt[(g * 64 + p) * 2], ai = abt[(g * 64 + p) * 2 + 1];
                const float* se = SEND + ((size_t)g * 1024 + b * NCH) * 128 + 2 * p;
                bf16* so = UEXT + ((size_t)g * 1024 + b * NCH) * UK + 512 + 2 * p;
                float sr = 0.f, si = 0.f;
                *(unsigned*)so = 0u;
                for (int c0 = 0; c0 < NCH; c0 += 16) { float er[16], ei[16];
#pragma unroll
                    for (int j = 0; j < 16; ++j) { const float2 e = *(const float2*)(se + (size_t)(c0 + j) * 128); er[j] = e.x; ei[j] = e.y; }
#pragma unroll
                    for (int j = 0; j < 16; ++j) { const float nr = ar * sr - ai * si + er[j], ni = ar * si + ai * sr + ei[j]; sr = nr; si = ni;
                        if (c0 + j + 1 < NCH) *(unsigned*)(so + (size_t)(c0 + j + 1) * UK) = cvt_pk_bf16(sr, si); } }
            }
            GRID_BAR();
            {   pg8::Gemm g{UEXT, Toep, UK, UK, UK, (size_t)1024 * UK * 2, (size_t)512 * UK * 2}; pg8::GroupOrder S; S.init(4, 2, 64, G, vcu);
                EpiS3 E{UEXT, P.in[21], T2};
                pg8::gemm_phase<EpiS3, pg8::GroupOrder, true>(lds, g, S, E, pr_acc); }
            GRID_BAR();
            {   pg8::Gemm g{T2, Wglu, D, D, D, 0, 0}; pg8::StaticOrder S; S.init(M, D, G, bid);
                EpiGlu E{T2, P.in[23], T3};
                pg8::gemm_phase<EpiGlu, pg8::StaticOrder, true>(lds, g, S, E, pr_acc); }
            GRID_BAR();
            PE(7);
            wout_t = Wso; aout = T3;
        } else {
            PB(6);
            {   pg8::Gemm g{XA, Wgi, D, D, D, 0, 0}; pg8::StaticOrder S; S.init(M, 2048, G, bid);
                EpiIn<2> E{partB, shw + (size_t)8 * mstart, 2048, T0, T1, partv};
                pg8::gemm_phase<EpiIn<2>, pg8::StaticOrder, true>(lds, g, S, E, pr_acc); }
            GRID_BAR();
            PE(6); PB(8);
            for (int cn = bid; cn < M / 128; cn += G) {
                LAS float* rstd_s = (LAS float*)lds; LAS bf16* wsA = (LAS bf16*)(lds + 1024); LAS bf16* vT = wsA + 128 * 136;
                const int wr = wave >> 1, wc = wave & 1, fr = lane & 15, fq = lane >> 4;
                __syncthreads();
                if (tid < 128) rstd_s[tid] = rstd_from(partv[cn * 128 + tid]);
                u32x4 wreg[4], vreg[4]; u32x2 ucur[2][4], unxt[2][4];
#define SG_LOAD(hd_) do { _Pragma("unroll") for (int j = 0; j < 4; ++j) { const int ch = tid + 512 * j, r = ch >> 4, c8 = (ch & 15) * 8; \
                        wreg[j] = *(const u32x4*)(WSt + (hd_) * 16384 + r * 128 + c8); vreg[j] = *(const u32x4*)(T1 + (size_t)(cn * 128 + r) * D + (hd_) * 128 + c8); } \
                    _Pragma("unroll") for (int mi = 0; mi < 2; ++mi) _Pragma("unroll") for (int ni = 0; ni < 4; ++ni) \
                        unxt[mi][ni] = *(const u32x2*)(T0 + (size_t)(cn * 128 + 32 * wr + 16 * mi + fr) * D + (hd_) * 128 + 64 * wc + 16 * ni + 4 * fq); } while (0)
                SG_LOAD(0);
                __syncthreads();
                for (int hd = 0; hd < 8; ++hd) {
#pragma unroll
                    for (int j = 0; j < 4; ++j) { const int ch = tid + 512 * j, r = ch >> 4, c8 = (ch & 15) * 8;
                        *(LAS u32x4*)(wsA + r * 136 + c8) = wreg[j];
                        f32x4 va, vb; unpack8(vreg[j], va, vb);
                        const float rs = rstd_s[r]; const f32x4 ga = *(const f32x4*)(P.in[26] + hd * 128 + c8), gb = *(const f32x4*)(P.in[26] + hd * 128 + c8 + 4);
                        va = va * rs * ga; vb = vb * rs * gb;
                        const int pc = r ^ c8;
#pragma unroll
                        for (int e = 0; e < 4; ++e) { vT[(c8 + e) * 136 + pc] = (bf16)(cvt_pk_bf16(va[e], 0.f) & 0xffffu); vT[(c8 + 4 + e) * 136 + pc] = (bf16)(cvt_pk_bf16(vb[e], 0.f) & 0xffffu); } }
#pragma unroll
                    for (int mi = 0; mi < 2; ++mi)
#pragma unroll
                        for (int ni = 0; ni < 4; ++ni) ucur[mi][ni] = unxt[mi][ni];
                    __syncthreads();
                    if (hd + 1 < 8) SG_LOAD(hd + 1);
                    f32x4 acc[2][4];
#pragma unroll
                    for (int mi = 0; mi < 2; ++mi)
#pragma unroll
                        for (int ni = 0; ni < 4; ++ni) acc[mi][ni] = (f32x4){0.f, 0.f, 0.f, 0.f};
                    for (int ks = 0; ks <= wr; ++ks) { bf16x8 a[2], bfr[4];
#pragma unroll
                        for (int mi = 0; mi < 2; ++mi) a[mi] = *(const LAS bf16x8*)(wsA + (32 * wr + 16 * mi + fr) * 136 + 32 * ks + 8 * fq);
#pragma unroll
                        for (int ni = 0; ni < 4; ++ni) { const int dh = 64 * wc + 16 * ni + fr; bfr[ni] = *(const LAS bf16x8*)(vT + dh * 136 + ((32 * ks + 8 * fq) ^ (dh & 0x78))); }
#pragma unroll
                        for (int mi = 0; mi < 2; ++mi)
#pragma unroll
                            for (int ni = 0; ni < 4; ++ni) acc[mi][ni] = __builtin_amdgcn_mfma_f32_16x16x32_bf16(bfr[ni], a[mi], acc[mi][ni], 0, 0, 0); }
#pragma unroll
                    for (int mi = 0; mi < 2; ++mi) { const int t = 32 * wr + 16 * mi + fr; const float bs = P.in[28][hd * 128 + t];
#pragma unroll
                        for (int ni = 0; ni < 4; ++ni) { const size_t off = (size_t)(cn * 128 + t) * D + hd * 128 + 64 * wc + 16 * ni + 4 * fq;
                            const u32x2 uw = ucur[mi][ni];
                            f32x4 uu; uu[0] = __uint_as_float(uw.x << 16); uu[1] = __uint_as_float(uw.x & 0xffff0000u); uu[2] = __uint_as_float(uw.y << 16); uu[3] = __uint_as_float(uw.y & 0xffff0000u);
                            const f32x4 o = uu * (acc[mi][ni] + bs); u32x2 w; w.x = cvt_pk_bf16(o[0], o[1]); w.y = cvt_pk_bf16(o[2], o[3]);
                            *(u32x2*)(T2 + off) = w; } }
                    __syncthreads();
                }
#undef SG_LOAD
            }
            GRID_BAR();
            PE(8);
            wout_t = Wgo; aout = T2;
        }
#pragma unroll 1
        for (int half = 0; half < 2; ++half) {
            if (half == 1) {
                PB(3);
                pg8::Gemm g{XA, W1t + (size_t)li * D * FF, D, D, D, 0, 0}; pg8::StaticOrder S; S.init(M, FF, G, bid);
                EpiIn<3> E{partA, shw + (size_t)8 * fstart, FF, HID, nullptr, nullptr};
                pg8::gemm_phase<EpiIn<3>, pg8::StaticOrder, true>(lds, g, S, E, pr_acc, PROBE_ID == 10 ? 2 : PROBE_ID == 13 ? 1 : 0);
                GRID_BAR();
                PE(3);
            }
            if (half == 0) PB(5); else PB(4);
            pg8::Gemm g; g.gsA = 0; g.gsB = 0;
            if (half == 0) { g.A = aout; g.Bt = wout_t; g.K = D; g.lda = D; g.ldb = D; }
            else { g.A = HID; g.Bt = W2t + (size_t)li * D * FF; g.K = FF; g.lda = FF; g.ldb = FF; }
            pg8::StaticOrder S; S.init(M, D, G, bid);
            EpiRes E; E.xin = XB; E.xout = XB; E.gate = mv + (half == 0 ? 2 : 5) * 8192;
            E.anext = half == 0 ? mv + 3 * 8192 : (li < 3 ? modv + (size_t)(li + 1) * 6 * 8192 : nullptr); E.xa = XA; E.padd = half == 0 ? partA : partB; E.pzero = half == 0 ? partB : partA;
            pg8::gemm_phase<EpiRes, pg8::StaticOrder, true>(lds, g, S, E, pr_acc, (PROBE_ID == 11 && half == 1) ? 2 : (PROBE_ID == 12 && half == 0) ? 2 : 0);
            GRID_BAR();
            if (half == 0) PE(5); else PE(4);
        }
        if (PROBE_ID == 9) { PB(9); GRID_BAR(); PE(9); }
    }
    if (PROBE_ID) { if (blockIdx.x == 0) { const unsigned long long t0 = __builtin_amdgcn_s_memrealtime(); while (__builtin_amdgcn_s_memrealtime() - t0 < PROBE_K * pr_acc) __builtin_amdgcn_s_sleep(8); } GRID_BAR(); }
    PB(2);
    FRESH_TID();
    for (int m0 = gw * 4; m0 < M; m0 += NGW * 4) {
        const f32x4* gr = (const f32x4*)P.in[8] + lane;
        u32x2 xr[4][4]; f32x4 v[4][4]; float s[4];
#pragma unroll
        for (int r = 0; r < 4; ++r)
#pragma unroll
            for (int j = 0; j < 4; ++j) xr[r][j] = *((const u32x2*)(XB + (size_t)(m0 + r) * D) + lane + 64 * j);
#pragma unroll
        for (int r = 0; r < 4; ++r) { s[r] = 0.f;
#pragma unroll
            for (int j = 0; j < 4; ++j) { const u32x2 w = xr[r][j]; v[r][j][0] = __uint_as_float(w.x << 16); v[r][j][1] = __uint_as_float(w.x & 0xffff0000u); v[r][j][2] = __uint_as_float(w.y << 16); v[r][j][3] = __uint_as_float(w.y & 0xffff0000u);
                s[r] += dot4(v[r][j]); } }
#pragma unroll
        for (int o = 1; o < 64; o <<= 1) {
#pragma unroll
            for (int r = 0; r < 4; ++r) s[r] += __shfl_xor(s[r], o); }
#pragma unroll
        for (int r = 0; r < 4; ++r) { const float rs = rsqrtf(s[r] * (1.0f / 1024.0f) + EPS);
#pragma unroll
            for (int j = 0; j < 4; ++j) *((f32x4*)(P.out + (size_t)(m0 + r) * D) + lane + 64 * j) = v[r][j] * rs * gr[64 * j]; }
    }
    if (PROBE_ID == 2) { GRID_BAR(); PE(2); if (blockIdx.x == 0) { const unsigned long long t0 = __builtin_amdgcn_s_memrealtime(); while (__builtin_amdgcn_s_memrealtime() - t0 < PROBE_K * pr_acc) __builtin_amdgcn_s_sleep(8); } GRID_BAR(); }
}

extern "C" void kernel_launch(void* const* d_in, const int* in_sizes, int n_in, void* d_out, int out_size, void* d_ws, size_t ws_size, hipStream_t stream) {
    static int grid = 0;
    if (grid == 0) {
        if (n_in != 30 || out_size != M * D || ws_size < WS_END) { fprintf(stderr, "kernel_launch: unexpected problem (n_in %d, out %d, ws %zu)\n", n_in, out_size, ws_size); grid = -1; return; }
        int dev = 0, cus = 0, per_cu = 0;
        hipGetDevice(&dev); hipDeviceGetAttribute(&cus, hipDeviceAttributeMultiprocessorCount, dev);
        if (hipFuncSetAttribute((const void*)mk_fwd, hipFuncAttributeMaxDynamicSharedMemorySize, LDS_BYTES) != hipSuccess) fprintf(stderr, "kernel_launch: hipFuncSetAttribute failed\n");
        if (hipOccupancyMaxActiveBlocksPerMultiprocessor(&per_cu, (const void*)mk_fwd, 512, LDS_BYTES) != hipSuccess || per_cu < 1) per_cu = 1;
        (void)hipGetLastError();
        grid = cus * per_cu; if (grid > 256) grid = 256; if (grid < 1) grid = 256;
    }
    if (grid < 0) return;
    Params p{};
    for (int i = 0; i < 30; ++i) p.in[i] = (const float*)d_in[i];
    p.out = (float*)d_out; p.ws = (unsigned char*)d_ws;
    void* args[] = {&p};
    if (hipMemsetAsync(d_ws, 0, 16384, stream) != hipSuccess) fprintf(stderr, "kernel_launch: memset of the barrier words failed\n");
    hipError_t e = hipLaunchCooperativeKernel((const void*)mk_fwd, dim3(grid), dim3(512), args, LDS_BYTES, stream);
    if (e != hipSuccess) fprintf(stderr, "cooperative launch failed: %s (grid %d)\n", hipGetErrorString(e), grid);
}
```
